# Optimizing an MI355X kernel written in HIP

```python
import math
import jax, jax.numpy as jnp
from jax import lax
import numpy as np

D_MODEL = 1024
BATCH = 4
SEQ = 4096
DEPTH = 1

GLA_HEADS = 4
GLA_DK = 64
GLA_DV = 128
GLA_RANK = 16
GLA_TAU = 16.0
GLA_CHUNK = 64
MOBA_HEADS = 8
MOBA_HD = 64
MOBA_BLOCK = 256
MOBA_TOPK = 3
MOBA_QCHUNK = 64
ROPE_THETA = 10000.0
MIX_WIDTH = GLA_HEADS * GLA_DV + MOBA_HEADS * MOBA_HD
IN_SPLITS = (GLA_HEADS * GLA_DK, GLA_HEADS * GLA_DK, GLA_HEADS * GLA_DV, GLA_HEADS * GLA_DV,
             GLA_RANK, MOBA_HEADS * MOBA_HD, MOBA_HEADS * MOBA_HD, MOBA_HEADS * MOBA_HD)
IN_WIDTH = sum(IN_SPLITS)
PEER_HEADS = 8
PEER_NKEYS = 128
PEER_N = PEER_NKEYS * PEER_NKEYS
PEER_QDIM = 256
PEER_TOPK = 16
PEER_TOKCHUNK = 128
EPS = 1e-6

kernel_name = "hymba_gla_moba_peer_layer"


def rmsnorm(x, w):
    xf = x.astype(jnp.float32)
    y = xf * lax.rsqrt(jnp.mean(xf * xf, axis=-1, keepdims=True) + EPS)
    return (y * w.astype(jnp.float32)).astype(x.dtype)


def rope(x, pos):
    hd = x.shape[-1]
    half = hd // 2
    inv = ROPE_THETA ** (-jnp.arange(half, dtype=jnp.float32) / half)
    ang = pos.astype(jnp.float32)[:, None] * inv[None, :]
    cos, sin = jnp.cos(ang), jnp.sin(ang)
    xf = x.astype(jnp.float32)
    x1, x2 = xf[..., :half], xf[..., half:]
    return jnp.concatenate([x1 * cos - x2 * sin, x2 * cos + x1 * sin], axis=-1).astype(x.dtype)


def to_heads(t, h):
    b, s, _ = t.shape
    return t.reshape(b, s, h, -1).transpose(0, 2, 1, 3)


def from_heads(t):
    b, h, s, d = t.shape
    return t.transpose(0, 2, 1, 3).reshape(b, s, h * d)


def gla_chunked(q, k, v, log_a):
    B, H, S, dk = q.shape
    dv = v.shape[-1]
    C = GLA_CHUNK
    nc = S // C
    q, k, g = (t.reshape(B, H, nc, C, dk) for t in (q, k, log_a))
    v = v.reshape(B, H, nc, C, dv)
    b = jnp.cumsum(g, axis=3)
    b_last = b[:, :, :, -1:, :]
    q_d = q * jnp.exp(b) * (dk ** -0.5)
    k_in = k * jnp.exp(-b)
    k_st = k * jnp.exp(b_last - b)
    causal = jnp.tril(jnp.ones((C, C), dtype=bool))
    A = jnp.where(causal, jnp.einsum('bhnid,bhnjd->bhnij', q_d, k_in), 0.0)
    o_intra = jnp.einsum('bhnij,bhnje->bhnie', A, v)
    upd = jnp.einsum('bhncd,bhnce->bhnde', k_st, v)
    decay = jnp.exp(b_last[:, :, :, 0, :])

    def step(state, inp):
        dec, u = inp
        return dec[..., None] * state + u, state

    init = jnp.zeros((B, H, dk, dv), jnp.float32)
    _, s_before = lax.scan(step, init, (jnp.moveaxis(decay, 2, 0), jnp.moveaxis(upd, 2, 0)))
    s_before = jnp.moveaxis(s_before, 0, 2)
    o_inter = jnp.einsum('bhncd,bhnde->bhnce', q_d, s_before)
    return (o_intra + o_inter).reshape(B, H, S, dv)


def moba_attention(q, k, v):
    B, H, S, hd = q.shape
    Sp = ((S + MOBA_BLOCK - 1) // MOBA_BLOCK) * MOBA_BLOCK
    padw = ((0, 0), (0, 0), (0, Sp - S), (0, 0))
    q, k, v = (jnp.pad(t, padw) for t in (q, k, v))
    nb = Sp // MOBA_BLOCK
    K = min(MOBA_TOPK, nb)
    kb = k.reshape(B, H, nb, MOBA_BLOCK, hd)
    vb = v.reshape(B, H, nb, MOBA_BLOCK, hd)
    kbar = jnp.mean(kb.astype(jnp.float32), axis=3)
    scale = hd ** -0.5
    bi = jnp.arange(B)[:, None, None, None]
    hi = jnp.arange(H)[None, :, None, None]
    nq = Sp // MOBA_QCHUNK

    def one_chunk(c):
        q0 = c * MOBA_QCHUNK
        qc = lax.dynamic_slice_in_dim(q, q0, MOBA_QCHUNK, axis=2)
        blk = q0 // MOBA_BLOCK
        bscore = jnp.einsum('bhqd,bhnd->bhqn', qc.astype(jnp.float32), kbar)
        bscore = jnp.where(jnp.arange(nb) < blk, bscore, -jnp.inf)
        _, idx = lax.top_k(bscore, K)
        valid = jnp.arange(K) < blk
        kg = kb[bi, hi, idx]
        vg = vb[bi, hi, idx]
        s_sel = jnp.einsum('bhqd,bhqkld->bhqkl', qc, kg).astype(jnp.float32) * scale
        s_sel = jnp.where(valid[:, None], s_sel, -jnp.inf)
        k_own = lax.dynamic_index_in_dim(kb, blk, axis=2, keepdims=False)
        v_own = lax.dynamic_index_in_dim(vb, blk, axis=2, keepdims=False)
        s_own = jnp.einsum('bhqd,bhld->bhql', qc, k_own).astype(jnp.float32) * scale
        qpos = q0 + jnp.arange(MOBA_QCHUNK)
        kpos = blk * MOBA_BLOCK + jnp.arange(MOBA_BLOCK)
        s_own = jnp.where(kpos[None, :] <= qpos[:, None], s_own, -jnp.inf)
        logits = jnp.concatenate([s_sel.reshape(B, H, MOBA_QCHUNK, K * MOBA_BLOCK), s_own], axis=-1)
        p = jax.nn.softmax(logits, axis=-1).astype(v.dtype)
        p_sel = p[..., :K * MOBA_BLOCK].reshape(B, H, MOBA_QCHUNK, K, MOBA_BLOCK)
        p_own = p[..., K * MOBA_BLOCK:]
        return (jnp.einsum('bhqkl,bhqkld->bhqd', p_sel, vg)
                + jnp.einsum('bhql,bhld->bhqd', p_own, v_own))

    out = lax.map(one_chunk, jnp.arange(nq))
    out = jnp.moveaxis(out, 0, 2).reshape(B, H, Sp, hd)
    return out[:, :, :S]


def peer_ffn(xn, w_query, subkeys, u_tab, v_tab):
    B, S, D = xn.shape
    T = B * S
    xt = xn.reshape(T, D)
    q = (xt @ w_query).reshape(T, PEER_HEADS, 2, PEER_QDIM // 2)
    s = jnp.einsum('thpd,hpkd->thpk', q, subkeys).astype(jnp.float32)
    sv, si = lax.top_k(s, PEER_TOPK)
    cand = (sv[:, :, 0, :, None] + sv[:, :, 1, None, :]).reshape(T, PEER_HEADS, PEER_TOPK * PEER_TOPK)
    cand_id = (si[:, :, 0, :, None] * PEER_NKEYS + si[:, :, 1, None, :]).reshape(T, PEER_HEADS, PEER_TOPK * PEER_TOPK)
    top_s, pos = lax.top_k(cand, PEER_TOPK)
    expert = jnp.take_along_axis(cand_id, pos, axis=-1)
    gate = jax.nn.softmax(top_s, axis=-1)
    nchunk = T // PEER_TOKCHUNK

    def apply(args):
        xc, ec, gc = args
        ug = u_tab[ec]
        vg = v_tab[ec]
        act = jax.nn.gelu(jnp.einsum('thkd,td->thk', ug, xc).astype(jnp.float32), approximate=False)
        w = (gc * act).astype(vg.dtype)
        return jnp.einsum('thk,thkd->td', w, vg)

    out = lax.map(apply, (xt.reshape(nchunk, PEER_TOKCHUNK, D),
                          expert.reshape(nchunk, PEER_TOKCHUNK, PEER_HEADS, PEER_TOPK),
                          gate.reshape(nchunk, PEER_TOKCHUNK, PEER_HEADS, PEER_TOPK)))
    return out.reshape(B, S, D)


def setup_inputs(seed: int = 0) -> dict:
    key = jax.random.key(seed)
    ks = jax.random.split(key, 15)
    L, D = DEPTH, D_MODEL
    nrm = jax.random.normal
    return {
        "x": nrm(ks[0], (BATCH, SEQ, D), jnp.float32),
        "norm1_w": 1.0 + 0.02 * nrm(ks[1], (L, D), jnp.float32),
        "w_in": nrm(ks[2], (L, D, IN_WIDTH), jnp.float32) * D ** -0.5,
        "gla_w_alpha": nrm(ks[3], (L, GLA_RANK, GLA_HEADS * GLA_DK), jnp.float32) * GLA_RANK ** -0.5,
        "gla_b_alpha": 0.1 * nrm(ks[4], (L, GLA_HEADS * GLA_DK), jnp.float32),
        "gla_out_norm_w": 1.0 + 0.02 * nrm(ks[5], (L, GLA_DV), jnp.float32),
        "moba_q_norm_w": 1.0 + 0.02 * nrm(ks[6], (L, MOBA_HD), jnp.float32),
        "moba_k_norm_w": 1.0 + 0.02 * nrm(ks[7], (L, MOBA_HD), jnp.float32),
        "mix_scale": 1.0 + 0.02 * nrm(ks[8], (L, MIX_WIDTH), jnp.float32),
        "w_out": nrm(ks[9], (L, MIX_WIDTH, D), jnp.float32) * MIX_WIDTH ** -0.5,
        "norm2_w": 1.0 + 0.02 * nrm(ks[10], (L, D), jnp.float32),
        "peer_w_query": nrm(ks[11], (L, D, PEER_HEADS * PEER_QDIM), jnp.float32) * D ** -0.5,
        "peer_subkeys": nrm(ks[12], (L, PEER_HEADS, 2, PEER_NKEYS, PEER_QDIM // 2), jnp.float32) * (PEER_QDIM // 2) ** -0.5,
        "peer_u": nrm(ks[13], (L, PEER_N, D), jnp.float32) * D ** -0.5,
        "peer_v": nrm(ks[14], (L, PEER_N, D), jnp.float32) * (PEER_HEADS * PEER_TOPK) ** -0.5,
    }


def reference(x, norm1_w, w_in, gla_w_alpha, gla_b_alpha, gla_out_norm_w, moba_q_norm_w,
              moba_k_norm_w, mix_scale, w_out, norm2_w, peer_w_query, peer_subkeys, peer_u, peer_v):
    B, S, _ = x.shape
    pos = jnp.arange(S)
    offsets = []
    acc = 0
    for w in IN_SPLITS[:-1]:
        acc += w
        offsets.append(acc)
    for l in range(DEPTH):
        xn = rmsnorm(x, norm1_w[l])
        proj = xn @ w_in[l]
        gq, gk, gv, ggate, gr, mq, mk, mv = jnp.split(proj, offsets, axis=-1)
        log_a = jax.nn.log_sigmoid((gr @ gla_w_alpha[l] + gla_b_alpha[l]).astype(jnp.float32)) / GLA_TAU
        o_gla = gla_chunked(to_heads(gq, GLA_HEADS).astype(jnp.float32),
                            to_heads(gk, GLA_HEADS).astype(jnp.float32),
                            to_heads(gv, GLA_HEADS).astype(jnp.float32),
                            to_heads(log_a, GLA_HEADS))
        o_gla = from_heads(rmsnorm(o_gla, gla_out_norm_w[l])).astype(x.dtype)
        o_gla = o_gla * jax.nn.silu(ggate)
        qh = rope(rmsnorm(to_heads(mq, MOBA_HEADS), moba_q_norm_w[l]), pos)
        kh = rope(rmsnorm(to_heads(mk, MOBA_HEADS), moba_k_norm_w[l]), pos)
        o_moba = from_heads(moba_attention(qh, kh, to_heads(mv, MOBA_HEADS)))
        mixed = jnp.concatenate([o_gla, o_moba], axis=-1) * mix_scale[l]
        x = x + mixed @ w_out[l]
        x = x + peer_ffn(rmsnorm(x, norm2_w[l]), peer_w_query[l], peer_subkeys[l], peer_u[l], peer_v[l])
    return x
```

```cpp
#include <hip/hip_runtime.h>
#include <hip/hip_cooperative_groups.h>
#include <cstdio>
namespace cg = cooperative_groups;

#define REP0 1
#ifndef SPLIT_GATHER
#define SPLIT_GATHER 2
#endif
#define REPG 1
#define REP4 1
#define REP3 1
#define REP8 1
#define REP9 1
#ifndef MEGA
#define MEGA 1
#endif

typedef unsigned short bf16_t;
typedef short bf16x8 __attribute__((ext_vector_type(8)));
typedef short bf16x4 __attribute__((ext_vector_type(4)));
typedef float f32x4 __attribute__((ext_vector_type(4)));
typedef unsigned u32x4 __attribute__((ext_vector_type(4)));
typedef unsigned u32x2 __attribute__((ext_vector_type(2)));
#define LAS __attribute__((address_space(3)))

constexpr int T_ = 16384, D_ = 1024, S_ = 4096;
constexpr int NPROJ = 3072;
constexpr int C_GQ = 0, C_GK = 256, C_GV = 512, C_GG = 1024, C_MQ = 1536, C_MK = 2048, C_MV = 2560;
constexpr int WIN_LD = 3088;
constexpr float EPS_ = 1e-6f;
constexpr int LDS_BYTES = 131072;
constexpr int NTHR = 512;

constexpr size_t MB = 1024 * 1024;
constexpr size_t WS_WIN = 0, WS_WOUT = 6 * MB, WS_WQ = 8 * MB, WS_U = 12 * MB, WS_V = 44 * MB, WS_XN = 76 * MB,
                 WS_PROJ = 108 * MB, WS_MIXED = 204 * MB, WS_GR = 236 * MB, WS_DECAY = 237 * MB,
                 WS_ROPE = 237 * MB + 256 * 1024, WS_SK = 238 * MB + 256 * 1024, WS_END = 239 * MB;
constexpr size_t OUT_GVT = 0, OUT_MVT = 16 * MB, OUT_KBAR = 32 * MB;

struct Params {
    const float *x, *norm1_w, *w_in, *w_alpha, *b_alpha, *gla_onw, *mqw, *mkw, *mix_scale, *w_out, *norm2_w, *w_query, *subkeys, *peer_u, *peer_v;
    float* out; unsigned char* ws; int ph_lo, ph_hi;
};

__device__ __forceinline__ bf16_t f2bf(float f) { unsigned u = __float_as_uint(f); u += 0x7FFFu + ((u >> 16) & 1u); return (bf16_t)(u >> 16); }
__device__ __forceinline__ float bf2f(bf16_t b) { return __uint_as_float(((unsigned)b) << 16); }
__device__ __forceinline__ unsigned pk2(float lo, float hi) { unsigned r; asm volatile("v_cvt_pk_bf16_f32 %0, %1, %2" : "=v"(r) : "v"(lo), "v"(hi)); return r; }
__device__ __forceinline__ float lo_f(unsigned w) { return __uint_as_float(w << 16); }
__device__ __forceinline__ float hi_f(unsigned w) { return __uint_as_float(w & 0xffff0000u); }
__device__ __forceinline__ void unpack8(const u32x4 w, float* f) { f[0] = lo_f(w.x); f[1] = hi_f(w.x); f[2] = lo_f(w.y); f[3] = hi_f(w.y); f[4] = lo_f(w.z); f[5] = hi_f(w.z); f[6] = lo_f(w.w); f[7] = hi_f(w.w); }
__device__ __forceinline__ float wave_sum(float v) { for (int o = 32; o > 0; o >>= 1) v += __shfl_xor(v, o); return v; }
__device__ __forceinline__ unsigned ordf(float f) { unsigned u = __float_as_uint(f); return (u & 0x80000000u) ? ~u : (u | 0x80000000u); }
__device__ __forceinline__ float unordf(unsigned o) { unsigned u = (o & 0x80000000u) ? (o & 0x7fffffffu) : ~o; return __uint_as_float(u); }
__device__ __forceinline__ bf16x8 as_bf16x8(u32x4 v) { union { u32x4 a; bf16x8 b; } t; t.a = v; return t.b; }
__device__ __forceinline__ bf16x8 as_bf16x8_2(u32x2 lo, u32x2 hi) { union { unsigned a[4]; bf16x8 b; } t; t.a[0] = lo.x; t.a[1] = lo.y; t.a[2] = hi.x; t.a[3] = hi.y; return t.b; }
__device__ __forceinline__ bf16x4 as_bf16x4(u32x2 v) { union { u32x2 a; bf16x4 b; } t; t.a = v; return t.b; }
__device__ __forceinline__ int otid() { int t = threadIdx.x; asm volatile("" : "+v"(t)); return t; }
__device__ __forceinline__ float gelu_erf(float v) {
    const float av = fabsf(v), t = __builtin_amdgcn_rcpf(av * 0.2316418882f + 1.0f);
    float q = t * 0.5307027145f + (-0.7265760135f); q = q * t + 0.7107068705f; q = q * t + (-0.142248368f); q = q * t + 0.127414796f; q = q * t;
    const float e = __builtin_amdgcn_exp2f((v * v) * (-0.72134752044f));
    const float m = v * (q * e);
    return v < 0.f ? m : v - m;
}
#define MFMA32(a, b, c) __builtin_amdgcn_mfma_f32_16x16x32_bf16((a), (b), (c), 0, 0, 0)
#define MFMA16(a, b, c) __builtin_amdgcn_mfma_f32_16x16x16bf16_1k((a), (b), (c), 0, 0, 0)

namespace pg8 {
constexpr int BM = 256, BK = 64, HALF = 128, HTB = HALF * BK * 2, NXCD = 8, WGM = 8;
__device__ __forceinline__ int lds_byte(int r, int c) { const int st = (r >> 4) * 2 + (c >> 5), rr = r & 15, cc = c & 31, ob = rr * 64 + cc * 2; return st * 1024 + (ob ^ (((ob >> 9) & 1) << 5)); }
__device__ __forceinline__ void stage_rc(int b, int& R, int& C) { const int st = b / 1024, sb = b % 1024, swz = sb ^ (((sb >> 9) & 1) << 5); R = (st >> 1) * 16 + swz / 64; C = (st & 1) * 32 + (swz % 64) / 2; }
__device__ __forceinline__ int perm32(int rho) { const int n = rho >> 4, i = rho & 15; return 8 * (i >> 2) + 4 * n + (i & 3); }
struct Unit { int pm, pn; };
struct Gemm { const bf16_t* A; const bf16_t* Bt; int M, N, K; };
struct StaticOrder {
    int nM, nN, nwg, G, c;
    __device__ void init(int M, int N, int G_, int c_) { nM = M / BM; nN = N / BM; nwg = nM * nN; G = G_; c = c_; }
    __device__ bool next(int i, Unit& u) const {
        const long L = (long)i * G + c; if (L >= nwg) return false;
        int wgid = (int)L; { const int q = nwg / NXCD, r = nwg % NXCD, xcd = wgid % NXCD, off = wgid / NXCD; wgid = (xcd < r ? xcd * (q + 1) : r * (q + 1) + (xcd - r) * q) + off; }
        const int nig = WGM * nN, gid = wgid / nig, fm = gid * WGM, gsz = (nM - fm) < WGM ? (nM - fm) : WGM;
        u.pm = fm + ((wgid % nig) % gsz); u.pn = (wgid % nig) / gsz; return true;
    }
};
struct EpiBf16Out {
    static constexpr bool PERM = true;
    bf16_t* O; int ldc;
    __device__ __forceinline__ void operator()(const f32x4 (&acc)[2][2][4][2], const Unit& u, int wr, int wc, int fr, int fq) const {
        const int row0 = u.pm * BM + wr * 64 + fr, col0 = u.pn * BM + wc * 32 + 8 * fq;
#pragma unroll
        for (int ai = 0; ai < 2; ++ai)
#pragma unroll
            for (int m = 0; m < 4; ++m) { bf16_t* rowp = O + (size_t)(row0 + ai * HALF + m * 16) * ldc + col0;
#pragma unroll
                for (int bj = 0; bj < 2; ++bj) { const f32x4 v0 = acc[ai][bj][m][0], v1 = acc[ai][bj][m][1];
                    u32x4 w; w.x = pk2(v0[0], v0[1]); w.y = pk2(v0[2], v0[3]); w.z = pk2(v1[0], v1[1]); w.w = pk2(v1[2], v1[3]);
                    *(u32x4*)(rowp + bj * HALF) = w; } }
    }
};
struct EpiResF32 {
    static constexpr bool PERM = false;
    float* C; const float* R; int ldc;
    __device__ __forceinline__ void operator()(const f32x4 (&acc)[2][2][4][2], const Unit& u, int wr, int wc, int fr, int fq) const {
        const int row0 = u.pm * BM + wr * 64 + fr, col0 = u.pn * BM + wc * 32 + 4 * fq;
#pragma unroll
        for (int ai = 0; ai < 2; ++ai)
#pragma unroll
            for (int m = 0; m < 4; ++m) { const size_t off = (size_t)(row0 + ai * HALF + m * 16) * ldc + col0;
#pragma unroll
                for (int bj = 0; bj < 2; ++bj)
#pragma unroll
                    for (int n = 0; n < 2; ++n) *(f32x4*)(C + off + bj * HALF + n * 16) = acc[ai][bj][m][n] + *(const f32x4*)(R + off + bj * HALF + n * 16); }
    }
};

template <class Epi>
__device__ __forceinline__ void gemm_phase(LAS unsigned char* lds, const Gemm g, const StaticOrder& S, const Epi& E) {
    const int tid = threadIdx.x, wid = __builtin_amdgcn_readfirstlane(tid >> 6), lane = tid & 63, wr = wid >> 2, wc = wid & 3, fr = lane & 15, fq = lane >> 4;
    const int K = g.K, nt = K / BK;
    unsigned voffA[2], voffB[2];
#pragma unroll
    for (int i = 0; i < 2; ++i) { int R, C; stage_rc(tid * 16 + i * 8192, R, C); const int Rb = Epi::PERM ? ((R & ~31) + perm32(R & 31)) : R;
        voffA[i] = (unsigned)(R * K + C) * 2u; voffB[i] = (unsigned)(Rb * K + C) * 2u; }
    const size_t kstep = (size_t)(BK * 2);
    const size_t hstep = (size_t)HALF * K * 2;
    const size_t tstep = 2 * hstep;
    const unsigned ldsw = (unsigned)wid * 1024u;
    const int aoff = lds_byte(wr * 64 + fr, fq * 8), boff = lds_byte(wc * 32 + fr, fq * 8);
#define PG8_SA(b, h) (((b) * 2 + (h)) * HTB)
#define PG8_SB(b, h) ((4 + (b) * 2 + (h)) * HTB)
#define PG8_STAGE(bufoff, gbase, voff) do { _Pragma("unroll") for (int _i = 0; _i < 2; ++_i) \
        __builtin_amdgcn_global_load_lds((const unsigned*)((const char*)(gbase) + (voff)[_i]), (LAS unsigned*)(lds + (bufoff) + ldsw + _i * 8192), 16, 0, 0); } while (0)
#define PG8_LDA(dst, b, h) do { _Pragma("unroll") for (int m = 0; m < 4; ++m) _Pragma("unroll") for (int k = 0; k < 2; ++k) dst[m][k] = *(const LAS bf16x8*)(lds + PG8_SA(b, h) + aoff + m * 2048 + k * 1024); } while (0)
#define PG8_LDB(dst, b, h) do { _Pragma("unroll") for (int n = 0; n < 2; ++n) _Pragma("unroll") for (int k = 0; k < 2; ++k) dst[n][k] = *(const LAS bf16x8*)(lds + PG8_SB(b, h) + boff + n * 2048 + k * 1024); } while (0)
#define PG8_MMA(ai, bj, At, Bt) do { __builtin_amdgcn_s_setprio(1); _Pragma("unroll") for (int m = 0; m < 4; ++m) _Pragma("unroll") for (int n = 0; n < 2; ++n) _Pragma("unroll") for (int k = 0; k < 2; ++k) \
        acc[ai][bj][m][n] = __builtin_amdgcn_mfma_f32_16x16x32_bf16(Bt[n][k], At[m][k], acc[ai][bj][m][n], 0, 0, 0); __builtin_amdgcn_s_setprio(0); } while (0)
#define PG8_WAIT_V(n) asm volatile("s_waitcnt vmcnt(" #n ")" ::: "memory")
#define PG8_WAIT_L(n) asm volatile("s_waitcnt lgkmcnt(" #n ")" ::: "memory")
#define PG8_BAR __builtin_amdgcn_s_barrier()
#define PG8_SCHED __builtin_amdgcn_sched_barrier(0)
    Unit cur, nxt; int ui = 0;
    if (!S.next(0, cur)) return;
    f32x4 acc[2][2][4][2];
#pragma unroll
    for (int a = 0; a < 2; ++a)
#pragma unroll
        for (int b = 0; b < 2; ++b)
#pragma unroll
            for (int m = 0; m < 4; ++m)
#pragma unroll
                for (int n = 0; n < 2; ++n) acc[a][b][m][n] = (f32x4){0.f, 0.f, 0.f, 0.f};
    bf16x8 At[4][2], B0[2][2], B1[2][2];
    const char* cA = (const char*)g.A + (size_t)cur.pm * tstep; const char* cB = (const char*)g.Bt + (size_t)cur.pn * tstep;
    PG8_STAGE(PG8_SB(0, 0), cB, voffB); PG8_STAGE(PG8_SA(0, 0), cA, voffA); PG8_STAGE(PG8_SB(0, 1), cB + hstep, voffB); PG8_STAGE(PG8_SA(0, 1), cA + hstep, voffA);
    if (wr == 1) PG8_BAR;
    PG8_WAIT_V(4); PG8_BAR;
    PG8_STAGE(PG8_SB(1, 0), cB + kstep, voffB); PG8_STAGE(PG8_SA(1, 0), cA + kstep, voffA); PG8_STAGE(PG8_SB(1, 1), cB + hstep + kstep, voffB);
    PG8_WAIT_V(6); PG8_BAR;
    for (;;) {
        const bool has_next = S.next(ui + 1, nxt);
        const char* nA = has_next ? (const char*)g.A + (size_t)nxt.pm * tstep : cA; const char* nB = has_next ? (const char*)g.Bt + (size_t)nxt.pn * tstep : cB;
        for (int t = 0; t < nt; t += 2) {
            const bool last = (t == nt - 2);
            const char* a1 = cA + (size_t)(t + 1) * kstep;
            const char* a2 = last ? nA : cA + (size_t)(t + 2) * kstep; const char* b2 = last ? nB : cB + (size_t)(t + 2) * kstep;
            const char* a3 = a2 + kstep; const char* b3 = b2 + kstep;
            PG8_LDB(B0, 0, 0); PG8_SCHED; PG8_LDA(At, 0, 0); PG8_STAGE(PG8_SA(1, 1), a1 + hstep, voffA);
            PG8_WAIT_L(8); PG8_BAR; PG8_WAIT_L(0); PG8_MMA(0, 0, At, B0); PG8_BAR; PG8_SCHED;
            PG8_LDB(B1, 0, 1); PG8_STAGE(PG8_SB(0, 0), b2, voffB);
            PG8_BAR; PG8_WAIT_L(0); PG8_MMA(0, 1, At, B1); PG8_BAR;
            PG8_LDA(At, 0, 1); PG8_STAGE(PG8_SA(0, 0), a2, voffA);
            PG8_BAR; PG8_WAIT_L(0); PG8_MMA(1, 0, At, B0); PG8_BAR; PG8_SCHED;
            PG8_STAGE(PG8_SB(0, 1), b2 + hstep, voffB);
            PG8_WAIT_V(6); PG8_BAR; PG8_MMA(1, 1, At, B1); PG8_BAR;
            PG8_LDB(B0, 1, 0); PG8_SCHED; PG8_LDA(At, 1, 0); PG8_STAGE(PG8_SA(0, 1), a2 + hstep, voffA);
            PG8_WAIT_L(8); PG8_BAR; PG8_WAIT_L(0); PG8_MMA(0, 0, At, B0); PG8_BAR; PG8_SCHED;
            PG8_LDB(B1, 1, 1); PG8_STAGE(PG8_SB(1, 0), b3, voffB);
            PG8_BAR; PG8_WAIT_L(0); PG8_MMA(0, 1, At, B1); PG8_BAR;
            PG8_LDA(At, 1, 1); PG8_STAGE(PG8_SA(1, 0), a3, voffA);
            PG8_BAR; PG8_WAIT_L(0); PG8_MMA(1, 0, At, B0); PG8_BAR; PG8_SCHED;
            PG8_STAGE(PG8_SB(1, 1), b3 + hstep, voffB);
            PG8_WAIT_V(6); PG8_BAR; PG8_MMA(1, 1, At, B1); PG8_BAR;
        }
        E(acc, cur, wr, wc, fr, fq);
        if (!has_next) break;
#pragma unroll
        for (int a = 0; a < 2; ++a)
#pragma unroll
            for (int b = 0; b < 2; ++b)
#pragma unroll
                for (int m = 0; m < 4; ++m)
#pragma unroll
                    for (int n = 0; n < 2; ++n) acc[a][b][m][n] = (f32x4){0.f, 0.f, 0.f, 0.f};
        cur = nxt; cA = nA; cB = nB; ++ui;
    }
    PG8_WAIT_V(0);
    if (wr == 0) PG8_BAR;
    PG8_BAR;
#undef PG8_SA
#undef PG8_SB
#undef PG8_STAGE
#undef PG8_LDA
#undef PG8_LDB
#undef PG8_MMA
#undef PG8_WAIT_V
#undef PG8_WAIT_L
#undef PG8_BAR
#undef PG8_SCHED
}
}

template <bool WITH_GR>
__device__ __forceinline__ void rmsnorm_rows(const float* src, const float* w, bf16_t* dst, float* gr_out, const float* wgrT) {
    const int lane = otid() & 63, wv = blockIdx.x * 8 + (otid() >> 6), nw = gridDim.x * 8;
    f32x4 wv4[4];
#pragma unroll
    for (int j = 0; j < 4; ++j) wv4[j] = *(const f32x4*)(w + j * 256 + lane * 4);
    for (int t = wv; t < T_; t += nw) {
        const float* row = src + (size_t)t * D_;
        f32x4 v[4]; float ss = 0.f;
#pragma unroll
        for (int j = 0; j < 4; ++j) { v[j] = *(const f32x4*)(row + j * 256 + lane * 4); ss += v[j][0] * v[j][0] + v[j][1] * v[j][1] + v[j][2] * v[j][2] + v[j][3] * v[j][3]; }
        ss = wave_sum(ss);
        const float rs = rsqrtf(ss * (1.0f / D_) + EPS_);
#pragma unroll
        for (int j = 0; j < 4; ++j) { v[j] = v[j] * rs * wv4[j];
            u32x2 o; o.x = pk2(v[j][0], v[j][1]); o.y = pk2(v[j][2], v[j][3]);
            *(u32x2*)(dst + (size_t)t * D_ + j * 256 + lane * 4) = o; }
        if (WITH_GR) {
            float pr[16];
#pragma unroll
            for (int r = 0; r < 16; ++r) { float pp = 0.f;
#pragma unroll
                for (int j = 0; j < 4; ++j) { const f32x4 ww = *(const f32x4*)(wgrT + r * 1024 + j * 256 + lane * 4); pp += v[j][0] * ww[0] + v[j][1] * ww[1] + v[j][2] * ww[2] + v[j][3] * ww[3]; }
                pr[r] = pp; }
            const bool b5 = lane & 32, b4 = lane & 16, b3 = lane & 8, b2 = lane & 4;
            float a8[8], a4[4], a2[2], a1;
#pragma unroll
            for (int i = 0; i < 8; ++i) { const float a = b5 ? pr[i + 8] : pr[i], bb = b5 ? pr[i] : pr[i + 8]; a8[i] = a + __shfl_xor(bb, 32); }
#pragma unroll
            for (int i = 0; i < 4; ++i) { const float a = b4 ? a8[i + 4] : a8[i], bb = b4 ? a8[i] : a8[i + 4]; a4[i] = a + __shfl_xor(bb, 16); }
#pragma unroll
            for (int i = 0; i < 2; ++i) { const float a = b3 ? a4[i + 2] : a4[i], bb = b3 ? a4[i] : a4[i + 2]; a2[i] = a + __shfl_xor(bb, 8); }
            { const float a = b2 ? a2[1] : a2[0], bb = b2 ? a2[0] : a2[1]; a1 = a + __shfl_xor(bb, 4); }
            a1 += __shfl_xor(a1, 2); a1 += __shfl_xor(a1, 1);
            const int ridx = ((lane >> 5) & 1) * 8 + ((lane >> 4) & 1) * 4 + ((lane >> 3) & 1) * 2 + ((lane >> 2) & 1);
            if ((lane & 3) == 0) gr_out[(size_t)t * 16 + ridx] = a1;
        }
    }
}

__device__ void phase_prep(const Params& p, unsigned char* shm) {
    const int tid = otid();
    float* wgrT = (float*)shm;
    float* tile = (float*)(shm + 65536);
    for (int idx = tid; idx < 16384; idx += NTHR) { const int k = idx >> 4, r = idx & 15; wgrT[r * 1024 + k] = p.w_in[(size_t)k * WIN_LD + 1536 + r]; }
    __syncthreads();
    rmsnorm_rows<true>(p.x, p.norm1_w, (bf16_t*)(p.ws + WS_XN), (float*)(p.ws + WS_GR), wgrT);
    for (int tl = blockIdx.x; tl < 1536; tl += gridDim.x) {
        const float* src; bf16_t* dst; int ld, kt, ntile, scol;
        if (tl < 768) { src = p.w_in; dst = (bf16_t*)(p.ws + WS_WIN); ld = WIN_LD; kt = tl & 15; ntile = tl >> 4; scol = ntile * 64 + (ntile * 64 >= 1536 ? 16 : 0); }
        else if (tl < 1024) { const int q = tl - 768; src = p.w_out; dst = (bf16_t*)(p.ws + WS_WOUT); ld = 1024; kt = q & 15; ntile = q >> 4; scol = ntile * 64; }
        else { const int q = tl - 1024; src = p.w_query; dst = (bf16_t*)(p.ws + WS_WQ); ld = 2048; kt = q & 15; ntile = q >> 4; scol = ntile * 64; }
        const int k0 = kt * 64, n0 = ntile * 64;
#pragma unroll
        for (int i = 0; i < 8; ++i) { const int r = (tid >> 6) + 8 * i, c = tid & 63; tile[r * 65 + c] = src[(size_t)(k0 + r) * ld + scol + c]; }
        __syncthreads();
#pragma unroll
        for (int i = 0; i < 8; ++i) { const int nn = (tid >> 6) + 8 * i, kk = tid & 63; dst[(size_t)(n0 + nn) * 1024 + k0 + kk] = f2bf(tile[kk * 65 + nn]); }
        __syncthreads();
    }
    const size_t gtid = (size_t)blockIdx.x * NTHR + tid, gn = (size_t)gridDim.x * NTHR;
    for (int which = 0; which < 2; ++which) {
        const float* src = which ? p.peer_v : p.peer_u; unsigned char* dst = p.ws + (which ? WS_V : WS_U); const float sc = which ? 64.0f : 256.0f;
        for (size_t i = gtid; i < (size_t)16384 * 1024 / 16; i += gn) {
            u32x4 o;
#pragma unroll
            for (int q4 = 0; q4 < 4; ++q4) { const f32x4 a = *(const f32x4*)(src + i * 16 + q4 * 4);
                int w = __builtin_amdgcn_cvt_pk_fp8_f32(a[0] * sc, a[1] * sc, 0, false); w = __builtin_amdgcn_cvt_pk_fp8_f32(a[2] * sc, a[3] * sc, w, true); o[q4] = (unsigned)w; }
            *(u32x4*)(dst + i * 16) = o; }
    }
    { bf16_t* dst = (bf16_t*)(p.ws + WS_SK);
      for (size_t i = gtid; i < (size_t)262144 / 8; i += gn) {
          const f32x4 a = *(const f32x4*)(p.subkeys + i * 8), b = *(const f32x4*)(p.subkeys + i * 8 + 4);
          u32x4 o; o.x = pk2(a[0], a[1]); o.y = pk2(a[2], a[3]); o.z = pk2(b[0], b[1]); o.w = pk2(b[2], b[3]);
          *(u32x4*)(dst + i * 8) = o; } }
    { float* rt = (float*)(p.ws + WS_ROPE);
      for (size_t i = gtid; i < (size_t)4096 * 32; i += gn) {
          const int pos = (int)(i >> 5), k = (int)(i & 31);
          const float inv = (float)exp(-(double)k * (9.210340371976184 / 32.0));
          const float ang = (float)pos * inv;
          double rev = (double)ang * 0.15915494309189535; rev -= floor(rev);
          rt[i] = __builtin_amdgcn_cosf((float)rev); rt[131072 + i] = __builtin_amdgcn_sinf((float)rev); } }
}

__device__ void moba_prep_item(const Params& p, unsigned char* shm, int item) {
    const int tid = otid();
    const int h = item & 7, blk = (item >> 3) & 15, b = item >> 7, bh = b * 8 + h;
    bf16_t* proj = (bf16_t*)(p.ws + WS_PROJ);
    const float* rope = (const float*)(p.ws + WS_ROPE);
    float* kt = (float*)shm;
    unsigned* vt = (unsigned*)(shm + 66560);
    float* part = (float*)(shm + 66560 + 33792);
    const int tl = tid & 255, which = tid >> 8;
    const size_t trow = (size_t)(b * S_ + blk * 256 + tl);
    {
        bf16_t* ptr = proj + trow * NPROJ + (which ? C_MK : C_MQ) + h * 64;
        const float* nw = which ? p.mkw : p.mqw;
        float v[64]; float ss = 0.f;
#pragma unroll
        for (int i = 0; i < 8; ++i) { const u32x4 w = *(const u32x4*)(ptr + i * 8); unpack8(w, v + i * 8); }
#pragma unroll
        for (int i = 0; i < 64; ++i) ss += v[i] * v[i];
        const float rs = rsqrtf(ss * (1.0f / 64) + EPS_);
        const float qsc = which ? 1.0f : 0.18033688f;
        const int pos = blk * 256 + tl;
        const float* cp = rope + (size_t)pos * 32; const float* sp = cp + 131072;
#pragma unroll
        for (int i = 0; i < 32; i += 4) {
            const f32x4 c4 = *(const f32x4*)(cp + i), s4 = *(const f32x4*)(sp + i), w1 = *(const f32x4*)(nw + i), w2 = *(const f32x4*)(nw + 32 + i);
#pragma unroll
            for (int j = 0; j < 4; ++j) { const float x1 = v[i + j] * rs * w1[j] * qsc, x2 = v[32 + i + j] * rs * w2[j] * qsc;
                v[i + j] = x1 * c4[j] - x2 * s4[j]; v[32 + i + j] = x2 * c4[j] + x1 * s4[j]; }
        }
#pragma unroll
        for (int i = 0; i < 8; ++i) { u32x4 w; w.x = pk2(v[i * 8], v[i * 8 + 1]); w.y = pk2(v[i * 8 + 2], v[i * 8 + 3]); w.z = pk2(v[i * 8 + 4], v[i * 8 + 5]); w.w = pk2(v[i * 8 + 6], v[i * 8 + 7]); *(u32x4*)(ptr + i * 8) = w; }
        if (which) {
#pragma unroll
            for (int i = 0; i < 64; ++i) kt[tl * 65 + i] = v[i];
        }
    }
    {
        const bf16_t* ptr = proj + trow * NPROJ + C_MV + h * 64 + which * 32;
#pragma unroll
        for (int i = 0; i < 4; ++i) { const u32x4 w = *(const u32x4*)(ptr + i * 8); unsigned* d = vt + tl * 33 + which * 16 + i * 4; d[0] = w.x; d[1] = w.y; d[2] = w.z; d[3] = w.w; }
    }
    __syncthreads();
    {
        const int d = tid & 63, pr = tid >> 6; float s = 0.f;
#pragma unroll 8
        for (int r = 0; r < 32; ++r) s += kt[(pr * 32 + r) * 65 + d];
        part[pr * 64 + d] = s;
    }
    {
        const int d = tid >> 3, seg = tid & 7;
        bf16_t* dst = (bf16_t*)((unsigned char*)p.out + OUT_MVT) + ((size_t)bh * 64 + d) * S_ + blk * 256 + seg * 32;
        const bf16_t* vs = (const bf16_t*)vt;
        unsigned o[16];
#pragma unroll
        for (int i = 0; i < 16; ++i) { const unsigned lo = vs[(seg * 32 + 2 * i) * 66 + d], hi = vs[(seg * 32 + 2 * i + 1) * 66 + d]; o[i] = lo | (hi << 16); }
#pragma unroll
        for (int i = 0; i < 4; ++i) { u32x4 w; w.x = o[i * 4]; w.y = o[i * 4 + 1]; w.z = o[i * 4 + 2]; w.w = o[i * 4 + 3]; *(u32x4*)(dst + i * 8) = w; }
    }
    __syncthreads();
    if (tid < 64) { float s = 0.f;
#pragma unroll
        for (int i = 0; i < 8; ++i) s += part[i * 64 + tid];
        ((float*)((unsigned char*)p.out + OUT_KBAR))[((size_t)bh * 16 + blk) * 64 + tid] = s * (1.0f / 256); }
    __syncthreads();
}

__device__ void gla_local_item(const Params& p, unsigned char* shm, int item) {
    const int tid = otid(), lane = tid & 63, wv = tid >> 6, g = lane >> 4, lr = lane & 15;
    const int n = item & 63, h = (item >> 6) & 3, b = item >> 8, bh = b * 4 + h;
    const size_t t0 = (size_t)b * S_ + n * 64;
    bf16_t* proj = (bf16_t*)(p.ws + WS_PROJ);
    float* gr_s = (float*)shm;
    float* wa_s = (float*)(shm + 4096);
    float* ba_s = (float*)(shm + 8192);
    float* g_s = (float*)(shm + 8704);
    float* tot_s = (float*)(shm + 8704 + 16384);
    bf16_t* kstT = (bf16_t*)(shm + 27136);
    bf16_t* vT = (bf16_t*)(shm + 27136 + 9216);
    const float* gr = (const float*)(p.ws + WS_GR);
    for (int i = tid; i < 1024; i += NTHR) { gr_s[i] = gr[t0 * 16 + i]; wa_s[i] = p.w_alpha[(size_t)(i >> 6) * 256 + h * 64 + (i & 63)]; }
    if (tid < 64) ba_s[tid] = p.b_alpha[h * 64 + tid];
    __syncthreads();
    { const int c = tid >> 3, dg = tid & 7;
#pragma unroll
      for (int dd = 0; dd < 8; ++dd) { const int d = dg * 8 + dd; float z = ba_s[d];
#pragma unroll
          for (int r = 0; r < 16; ++r) z += gr_s[c * 16 + r] * wa_s[r * 64 + d];
          const float ls = fminf(z, 0.f) - __logf(1.0f + __expf(-fabsf(z)));
          g_s[c * 64 + d] = ls * (1.0f / 16.0f); } }
    __syncthreads();
    { const int d = tid & 63, seg = tid >> 6; float run = 0.f;
#pragma unroll
      for (int i = 0; i < 8; ++i) { run += g_s[(seg * 8 + i) * 64 + d]; g_s[(seg * 8 + i) * 64 + d] = run; }
      tot_s[seg * 64 + d] = run; }
    __syncthreads();
    { const int d = tid & 63, seg = tid >> 6; float off = 0.f;
      for (int s = 0; s < seg; ++s) off += tot_s[s * 64 + d];
#pragma unroll
      for (int i = 0; i < 8; ++i) g_s[(seg * 8 + i) * 64 + d] += off; }
    __syncthreads();
    { const int c = tid >> 3, dg = tid & 7;
      bf16_t* qp = proj + (t0 + c) * NPROJ + C_GQ + h * 64 + dg * 8; bf16_t* kp = proj + (t0 + c) * NPROJ + C_GK + h * 64 + dg * 8;
      float q[8], k[8]; unpack8(*(const u32x4*)qp, q); unpack8(*(const u32x4*)kp, k);
      float qd[8], ki[8];
#pragma unroll
      for (int dd = 0; dd < 8; ++dd) { const int d = dg * 8 + dd; const float bb = g_s[c * 64 + d], bl = g_s[63 * 64 + d];
          qd[dd] = q[dd] * __expf(bb) * 0.125f; ki[dd] = k[dd] * __expf(-bb); kstT[d * 72 + c] = f2bf(k[dd] * __expf(bl - bb)); }
      u32x4 w; w.x = pk2(qd[0], qd[1]); w.y = pk2(qd[2], qd[3]); w.z = pk2(qd[4], qd[5]); w.w = pk2(qd[6], qd[7]); *(u32x4*)qp = w;
      w.x = pk2(ki[0], ki[1]); w.y = pk2(ki[2], ki[3]); w.z = pk2(ki[4], ki[5]); w.w = pk2(ki[6], ki[7]); *(u32x4*)kp = w;
      const bf16_t* vp = proj + (t0 + c) * NPROJ + C_GV + h * 128 + dg * 16;
#pragma unroll
      for (int i = 0; i < 2; ++i) { const u32x4 vv = *(const u32x4*)(vp + i * 8); const int e0 = dg * 16 + i * 8;
          vT[(e0 + 0) * 72 + c] = (bf16_t)(vv.x & 0xffff); vT[(e0 + 1) * 72 + c] = (bf16_t)(vv.x >> 16);
          vT[(e0 + 2) * 72 + c] = (bf16_t)(vv.y & 0xffff); vT[(e0 + 3) * 72 + c] = (bf16_t)(vv.y >> 16);
          vT[(e0 + 4) * 72 + c] = (bf16_t)(vv.z & 0xffff); vT[(e0 + 5) * 72 + c] = (bf16_t)(vv.z >> 16);
          vT[(e0 + 6) * 72 + c] = (bf16_t)(vv.w & 0xffff); vT[(e0 + 7) * 72 + c] = (bf16_t)(vv.w >> 16); }
      if (tid < 64) ((float*)(p.ws + WS_DECAY))[((size_t)bh * 64 + n) * 64 + tid] = expf(g_s[63 * 64 + tid]);
    }
    __syncthreads();
    {
      const int e = tid >> 2, cs = tid & 3;
      bf16_t* dst = (bf16_t*)((unsigned char*)p.out + OUT_GVT) + ((size_t)bh * 128 + e) * S_ + n * 64 + cs * 16;
      *(u32x4*)dst = *(const u32x4*)(vT + e * 72 + cs * 16); *(u32x4*)(dst + 8) = *(const u32x4*)(vT + e * 72 + cs * 16 + 8); }
    {
      f32x4 acc[4];
#pragma unroll
      for (int dt = 0; dt < 4; ++dt) acc[dt] = (f32x4){0.f, 0.f, 0.f, 0.f};
#pragma unroll
      for (int ks = 0; ks < 2; ++ks) { const bf16x8 a = *(const bf16x8*)(vT + (wv * 16 + lr) * 72 + ks * 32 + g * 8);
#pragma unroll
          for (int dt = 0; dt < 4; ++dt) { const bf16x8 bb = *(const bf16x8*)(kstT + (dt * 16 + lr) * 72 + ks * 32 + g * 8); acc[dt] = MFMA32(a, bb, acc[dt]); } }
      float* st = (float*)(p.ws + WS_XN) + ((size_t)bh * 64 + n) * 8192;
#pragma unroll
      for (int dt = 0; dt < 4; ++dt)
#pragma unroll
          for (int j = 0; j < 4; ++j) st[(wv * 16 + g * 4 + j) * 64 + dt * 16 + lr] = acc[dt][j]; }
    __syncthreads();
}

__device__ void phase_mixprep(const Params& p, unsigned char* shm) {
    for (int it = blockIdx.x; it < 1536; it += gridDim.x) { if (it < 512) moba_prep_item(p, shm, it); else gla_local_item(p, shm, it - 512); }
}

__device__ void gla_scan(const Params& p) {
    const int gid = blockIdx.x * NTHR + otid(), gn = gridDim.x * NTHR;
    float* st = (float*)(p.ws + WS_XN); const float* dec = (const float*)(p.ws + WS_DECAY);
    for (int e = gid; e < 16 * 8192; e += gn) {
        const int bh = e >> 13, el = e & 8191, d = el & 63; float s = 0.f;
        for (int n0 = 0; n0 < 64; n0 += 8) { float u[8], dc[8];
#pragma unroll
            for (int k = 0; k < 8; ++k) { u[k] = st[((size_t)bh * 64 + n0 + k) * 8192 + el]; dc[k] = dec[((size_t)bh * 64 + n0 + k) * 64 + d]; }
#pragma unroll
            for (int k = 0; k < 8; ++k) { st[((size_t)bh * 64 + n0 + k) * 8192 + el] = s; s = dc[k] * s + u[k]; } }
    }
}

__device__ void moba_attn_item(const Params& p, unsigned char* shm, int bh, int blk) {
    const int tid = otid(), lane = tid & 63, wv = tid >> 6, g = lane >> 4, lr = lane & 15;
    const int b = bh >> 3, h = bh & 7, q0 = blk * 256;
    const bf16_t* proj = (const bf16_t*)(p.ws + WS_PROJ);
    const bf16_t* mvT = (const bf16_t*)((unsigned char*)p.out + OUT_MVT) + (size_t)bh * 64 * S_;
    const float* kbar = (const float*)((unsigned char*)p.out + OUT_KBAR) + (size_t)bh * 16 * 64;
    bf16_t* Ks = (bf16_t*)shm;
    bf16_t* VTs = (bf16_t*)(shm + 36864);
    unsigned* sel_s = (unsigned*)(shm + 36864 + 34816);
    if (tid == 0) sel_s[256] = 0u;
    if (tid < 64) {
        float aq = fabsf(p.mqw[tid]), ak = fabsf(p.mkw[tid]);
        for (int o = 32; o > 0; o >>= 1) { aq = fmaxf(aq, __shfl_xor(aq, o)); ak = fmaxf(ak, __shfl_xor(ak, o)); }
        if (tid == 0) ((float*)sel_s)[257] = 8.2f * aq * ak * 1.44269504f;
    }
    __syncthreads();
    if (tid < 256) {
        unsigned mask;
        if (blk <= 3) mask = (1u << blk) - 1u;
        else {
            float q[64]; const bf16_t* qp = proj + ((size_t)b * S_ + q0 + tid) * NPROJ + C_MQ + h * 64;
#pragma unroll
            for (int i = 0; i < 8; ++i) unpack8(*(const u32x4*)(qp + i * 8), q + i * 8);
            float v0 = -INFINITY, v1 = -INFINITY, v2 = -INFINITY; int i0 = 0, i1 = 0, i2 = 0;
            for (int j = 0; j < blk; ++j) { float s = 0.f;
#pragma unroll
                for (int i = 0; i < 64; i += 4) { const f32x4 kk = *(const f32x4*)(kbar + j * 64 + i); s += q[i] * kk[0] + q[i + 1] * kk[1] + q[i + 2] * kk[2] + q[i + 3] * kk[3]; }
                if (s > v0) { v2 = v1; i2 = i1; v1 = v0; i1 = i0; v0 = s; i0 = j; } else if (s > v1) { v2 = v1; i2 = i1; v1 = s; i1 = j; } else if (s > v2) { v2 = s; i2 = j; } }
            mask = (1u << i0) | (1u << i1) | (1u << i2);
        }
        sel_s[tid] = mask; atomicOr(&sel_s[256], mask);
    }
    __syncthreads();
    const unsigned umask = sel_s[256]; const float mbound = ((const float*)sel_s)[257];
    unsigned mysel[2]; int qabs[2]; bf16x8 qb[2][2]; f32x4 acc[2][4], lacc[2];
    const bf16x8 ones = {(short)0x3F80, (short)0x3F80, (short)0x3F80, (short)0x3F80, (short)0x3F80, (short)0x3F80, (short)0x3F80, (short)0x3F80};
#pragma unroll
    for (int u = 0; u < 2; ++u) {
        mysel[u] = sel_s[wv * 32 + u * 16 + lr]; qabs[u] = q0 + wv * 32 + u * 16 + lr;
        const bf16_t* qp = proj + ((size_t)b * S_ + qabs[u]) * NPROJ + C_MQ + h * 64 + g * 8; qb[u][0] = *(const bf16x8*)qp; qb[u][1] = *(const bf16x8*)(qp + 32);
#pragma unroll
        for (int dt = 0; dt < 4; ++dt) acc[u][dt] = (f32x4){0.f, 0.f, 0.f, 0.f};
        lacc[u] = (f32x4){0.f, 0.f, 0.f, 0.f}; }
    const int bp32 = (lane ^ 32) * 4;
    u32x4 kreg[4], vreg[4];
    int j = 0; while (j < blk && !((umask >> j) & 1u)) ++j;
#define MOBA_LOAD(jj) do { _Pragma("unroll") for (int i = 0; i < 4; ++i) { const int c = tid + NTHR * i; \
            kreg[i] = *(const u32x4*)(proj + ((size_t)b * S_ + (jj) * 256 + (c >> 3)) * NPROJ + C_MK + h * 64 + (c & 7) * 8); \
            vreg[i] = *(const u32x4*)(mvT + (size_t)(c >> 5) * S_ + (jj) * 256 + (c & 31) * 8); } } while (0)
#define MOBA_STORE() do { _Pragma("unroll") for (int i = 0; i < 4; ++i) { const int c = tid + NTHR * i; \
            *(u32x4*)(Ks + (c >> 3) * 72 + (c & 7) * 8) = kreg[i]; *(u32x4*)(VTs + (c >> 5) * 272 + (c & 31) * 8) = vreg[i]; } } while (0)
    MOBA_LOAD(j); MOBA_STORE();
    __syncthreads();
    while (j <= blk) {
        int jn = j + 1; while (jn < blk && !((umask >> jn) & 1u)) ++jn;
        if (jn <= blk) MOBA_LOAD(jn);
        const bool own = (j == blk);
        const bool on0 = own || ((mysel[0] >> j) & 1u), on1 = own || ((mysel[1] >> j) & 1u);
        if (__any(on0 || on1)) {
            const float bias[2] = {on0 ? -mbound : -INFINITY, on1 ? -mbound : -INFINITY};
            const int kend = own ? wv + 1 : 8;
            for (int kk = 0; kk < kend; ++kk) {
                bf16x8 kf[2][2];
#pragma unroll
                for (int hf = 0; hf < 2; ++hf) { const bf16_t* kp = Ks + (kk * 32 + hf * 16 + lr) * 72 + g * 8; kf[hf][0] = *(const bf16x8*)kp; kf[hf][1] = *(const bf16x8*)(kp + 32); }
                bf16x8 vf[4];
#pragma unroll
                for (int dt = 0; dt < 4; ++dt) { const bf16_t* vp = VTs + (dt * 16 + lr) * 272 + kk * 32 + g * 4; vf[dt] = as_bf16x8_2(*(const u32x2*)vp, *(const u32x2*)(vp + 16)); }
                const bool diag = own && (kk == wv);
                bf16x8 pb[2];
#pragma unroll
                for (int u = 0; u < 2; ++u) {
                    f32x4 st[2];
#pragma unroll
                    for (int hf = 0; hf < 2; ++hf) { st[hf] = MFMA32(kf[hf][0], qb[u][0], ((f32x4){bias[u], bias[u], bias[u], bias[u]})); st[hf] = MFMA32(kf[hf][1], qb[u][1], st[hf]); }
                    float sv[8];
#pragma unroll
                    for (int hf = 0; hf < 2; ++hf)
#pragma unroll
                        for (int jj = 0; jj < 4; ++jj) sv[hf * 4 + jj] = st[hf][jj];
                    if (diag) {
#pragma unroll
                        for (int hf = 0; hf < 2; ++hf)
#pragma unroll
                            for (int jj = 0; jj < 4; ++jj) if (j * 256 + kk * 32 + hf * 16 + g * 4 + jj > qabs[u]) sv[hf * 4 + jj] = -INFINITY;
                    }
                    float pv[8];
#pragma unroll
                    for (int i = 0; i < 8; ++i) pv[i] = __builtin_amdgcn_exp2f(sv[i]);
                    u32x4 pw; pw.x = pk2(pv[0], pv[1]); pw.y = pk2(pv[2], pv[3]); pw.z = pk2(pv[4], pv[5]); pw.w = pk2(pv[6], pv[7]);
                    pb[u] = as_bf16x8(pw);
                }
#pragma unroll
                for (int u = 0; u < 2; ++u) {
#pragma unroll
                    for (int dt = 0; dt < 4; ++dt) acc[u][dt] = MFMA32(vf[dt], pb[u], acc[u][dt]);
                    lacc[u] = MFMA32(ones, pb[u], lacc[u]); }
            }
        }
        __syncthreads();
        if (jn <= blk) MOBA_STORE();
        __syncthreads();
        j = jn;
    }
#undef MOBA_LOAD
#undef MOBA_STORE
#pragma unroll
    for (int u = 0; u < 2; ++u) {
        const float il = 1.0f / lacc[u][0];
        bf16_t* mixed = (bf16_t*)(p.ws + WS_MIXED) + ((size_t)b * S_ + qabs[u]) * 1024 + 512 + h * 64;
#pragma unroll
        for (int dt = 0; dt < 4; ++dt) { const f32x4 sc = *(const f32x4*)(p.mix_scale + 512 + h * 64 + dt * 16 + g * 4);
            u32x2 o; o.x = pk2(acc[u][dt][0] * il * sc[0], acc[u][dt][1] * il * sc[1]); o.y = pk2(acc[u][dt][2] * il * sc[2], acc[u][dt][3] * il * sc[3]);
            *(u32x2*)(mixed + dt * 16 + g * 4) = o; }
    }
}

__device__ void phase_moba(const Params& p, unsigned char* shm) {
    for (int it = blockIdx.x; it < 512; it += gridDim.x) {
        const int j = it & 255, r = it >> 8, a = j >> 5, bh = j & 31;
        moba_attn_item(p, shm, bh, r ? 15 - a : a);
    }
}
__device__ void phase_scan_moba(const Params& p, unsigned char* shm) { gla_scan(p); phase_moba(p, shm); }

__device__ void gla_out_task(const Params& p, int item, int it) {
    const int lane = otid() & 63, g = lane >> 4, lr = lane & 15;
    const int n = item & 63, h = (item >> 6) & 3, b = item >> 8, bh = b * 4 + h;
    const size_t t0 = (size_t)b * S_ + n * 64; const int i0 = it * 16;
    const bf16_t* proj = (const bf16_t*)(p.ws + WS_PROJ);
    const bf16_t* gvT = (const bf16_t*)((unsigned char*)p.out + OUT_GVT) + (size_t)bh * 128 * S_ + n * 64;
    const float* st = (const float*)(p.ws + WS_XN) + ((size_t)bh * 64 + n) * 8192;
    bf16x8 qd[2];
    { const bf16_t* qp = proj + (t0 + i0 + lr) * NPROJ + C_GQ + h * 64 + g * 8; qd[0] = *(const bf16x8*)qp; qd[1] = *(const bf16x8*)(qp + 32); }
    f32x4 acc[8];
#pragma unroll
    for (int et = 0; et < 8; ++et) acc[et] = (f32x4){0.f, 0.f, 0.f, 0.f};
#pragma unroll
    for (int et = 0; et < 8; ++et)
#pragma unroll
        for (int ks = 0; ks < 2; ++ks) { const float* sp = st + (et * 16 + lr) * 64 + ks * 32 + g * 8; const f32x4 a = *(const f32x4*)sp, c = *(const f32x4*)(sp + 4);
            u32x4 w; w.x = pk2(a[0], a[1]); w.y = pk2(a[2], a[3]); w.z = pk2(c[0], c[1]); w.w = pk2(c[2], c[3]);
            acc[et] = MFMA32(as_bf16x8(w), qd[ks], acc[et]); }
    for (int jt = 0; jt <= it; ++jt) {
        const int j0 = jt * 16;
        const bf16_t* kp = proj + (t0 + j0 + lr) * NPROJ + C_GK + h * 64 + g * 8;
        f32x4 at = MFMA32(*(const bf16x8*)kp, qd[0], ((f32x4){0.f, 0.f, 0.f, 0.f})); at = MFMA32(*(const bf16x8*)(kp + 32), qd[1], at);
#pragma unroll
        for (int jj = 0; jj < 4; ++jj) if (j0 + g * 4 + jj > i0 + lr) at[jj] = 0.f;
        u32x2 aw; aw.x = pk2(at[0], at[1]); aw.y = pk2(at[2], at[3]);
        const bf16x4 ab = as_bf16x4(aw);
#pragma unroll
        for (int et = 0; et < 8; ++et) { const u32x2 vv = *(const u32x2*)(gvT + (size_t)(et * 16 + lr) * S_ + j0 + g * 4); acc[et] = MFMA16(as_bf16x4(vv), ab, acc[et]); }
    }
    float ss = 0.f;
#pragma unroll
    for (int et = 0; et < 8; ++et) ss += acc[et][0] * acc[et][0] + acc[et][1] * acc[et][1] + acc[et][2] * acc[et][2] + acc[et][3] * acc[et][3];
    ss += __shfl_xor(ss, 16); ss += __shfl_xor(ss, 32);
    const float rs = rsqrtf(ss * (1.0f / 128) + EPS_);
    const size_t t = t0 + i0 + lr;
    bf16_t* mixed = (bf16_t*)(p.ws + WS_MIXED) + t * 1024 + h * 128;
#pragma unroll
    for (int et = 0; et < 8; ++et) { const int e0 = et * 16 + g * 4;
        const f32x4 w = *(const f32x4*)(p.gla_onw + e0), sc = *(const f32x4*)(p.mix_scale + h * 128 + e0);
        const u32x2 gw = *(const u32x2*)(proj + t * NPROJ + C_GG + h * 128 + e0);
        const float gt[4] = {lo_f(gw.x), hi_f(gw.x), lo_f(gw.y), hi_f(gw.y)}; float y[4];
#pragma unroll
        for (int j = 0; j < 4; ++j) { const float sl = gt[j] / (1.0f + __expf(-gt[j])); y[j] = acc[et][j] * rs * w[j] * sl * sc[j]; }
        u32x2 o; o.x = pk2(y[0], y[1]); o.y = pk2(y[2], y[3]); *(u32x2*)(mixed + e0) = o; }
}
__device__ void phase_gla_out(const Params& p) {
    const int wg = blockIdx.x * 8 + (otid() >> 6), nw = gridDim.x * 8; int rnd = 0;
    for (int tk = wg; tk < 4096; tk += nw, ++rnd) { const int it = (rnd & 1) ? 3 - (tk & 3) : (tk & 3); gla_out_task(p, tk >> 2, it); }
}

__constant__ unsigned char c_stair[52] = {
    0x00, 0x01, 0x02, 0x03, 0x04, 0x05, 0x06, 0x07, 0x08, 0x09, 0x0a, 0x0b, 0x0c, 0x0d, 0x0e, 0x0f,
    0x10, 0x11, 0x12, 0x13, 0x14, 0x15, 0x16, 0x17, 0x20, 0x21, 0x22, 0x23, 0x24, 0x30, 0x31, 0x32, 0x33,
    0x40, 0x41, 0x42, 0x50, 0x51, 0x60, 0x61, 0x70, 0x71, 0x80, 0x90, 0xa0, 0xb0, 0xc0, 0xd0, 0xe0, 0xf0, 0x00, 0x00};

__device__ void peer_topk_task(const Params& p, unsigned char* shm, int grp, int h, int grp_next, bf16x8 (&qn)[4]) {
    const int lane = otid() & 63, wv = otid() >> 6, g = lane >> 4, lr = lane & 15;
    const bf16_t* sk_s = (const bf16_t*)shm;
    float* sv_s = (float*)(shm + 69632 + wv * 4096);
    int* si_s = (int*)(shm + 69632 + wv * 4096 + 2048);
    const unsigned char* stair_s = (const unsigned char*)(shm + 69632 + 8 * 4096);
    const bf16_t* q = (const bf16_t*)(p.ws + WS_PROJ) + ((size_t)grp * 16 + lr) * 2048 + h * 256;
    const int bp32 = (lane ^ 32) * 4;
#pragma unroll 1
    for (int pp = 0; pp < 2; ++pp) {
        bf16x8 qf[4];
#pragma unroll
        for (int ks = 0; ks < 4; ++ks) qf[ks] = qn[ks];
        {
            const bf16_t* qx = (pp == 0) ? q + 128 : (const bf16_t*)(p.ws + WS_PROJ) + ((size_t)grp_next * 16 + lr) * 2048 + h * 256;
            if (pp == 0 || grp_next >= 0) {
#pragma unroll
                for (int ks = 0; ks < 4; ++ks) qn[ks] = *(const bf16x8*)(qx + ks * 32 + g * 8); }
        }
        unsigned pk[32];
#pragma unroll
        for (int kt = 0; kt < 8; ++kt) { f32x4 a = (f32x4){0.f, 0.f, 0.f, 0.f};
#pragma unroll
            for (int ks = 0; ks < 4; ++ks) a = MFMA32(*(const bf16x8*)(sk_s + (pp * 128 + kt * 16 + lr) * 136 + ks * 32 + g * 8), qf[ks], a);
#pragma unroll
            for (int jj = 0; jj < 4; ++jj) pk[kt * 4 + jj] = (ordf(a[jj]) & ~127u) | (unsigned)(127 - (kt * 16 + g * 4 + jj)); }
        unsigned thr = 0u;
#pragma unroll 1
        for (int r = 0; r < 16; ++r) {
            unsigned dm = pk[0] - thr;
#pragma unroll
            for (int i = 1; i < 32; ++i) dm = max(dm, pk[i] - thr);
            dm = max(dm, (unsigned)__builtin_amdgcn_ds_swizzle((int)dm, 0x401F)); dm = max(dm, (unsigned)__builtin_amdgcn_ds_bpermute(bp32, (int)dm));
            const unsigned mm = dm + thr; thr = mm;
            if (g == 0) { sv_s[(pp * 16 + r) * 16 + lr] = unordf(mm & ~127u); si_s[(pp * 16 + r) * 16 + lr] = 127 - (int)(mm & 127u); }
        }
    }
    __builtin_amdgcn_wave_barrier();
    unsigned cp[13];
#pragma unroll
    for (int mi = 0; mi < 13; ++mi) { const int c = g + 4 * mi; const int ij = stair_s[c];
        const float val = sv_s[(ij >> 4) * 16 + lr] + sv_s[(16 + (ij & 15)) * 16 + lr];
        cp[mi] = (c < 50) ? ((ordf(val) & ~63u) | (unsigned)(63 - c)) : 0u; }
    float ts[16]; int ex[16];
    unsigned cthr = 0u;
#pragma unroll
    for (int r = 0; r < 16; ++r) {
        unsigned dm = cp[0] - cthr;
#pragma unroll
        for (int i = 1; i < 13; ++i) dm = max(dm, cp[i] - cthr);
        dm = max(dm, (unsigned)__builtin_amdgcn_ds_swizzle((int)dm, 0x401F)); dm = max(dm, (unsigned)__builtin_amdgcn_ds_bpermute(bp32, (int)dm));
        const unsigned mm = dm + cthr; cthr = mm;
        const int c = 63 - (int)(mm & 63u); const int ij = stair_s[c];
        ts[r] = sv_s[(ij >> 4) * 16 + lr] + sv_s[(16 + (ij & 15)) * 16 + lr];
        ex[r] = si_s[(ij >> 4) * 16 + lr] * 128 + si_s[(16 + (ij & 15)) * 16 + lr];
    }
    float mx = ts[0];
#pragma unroll
    for (int r = 1; r < 16; ++r) mx = fmaxf(mx, ts[r]);
    float sum = 0.f;
#pragma unroll
    for (int r = 0; r < 16; ++r) { ts[r] = __expf(ts[r] - mx); sum += ts[r]; }
    const float inv = 1.0f / sum;
    if (g == 0) {
        int* eo = (int*)(p.ws + WS_MIXED) + ((size_t)grp * 16 + lr) * 128 + h * 16;
        float* go = (float*)(p.ws + WS_MIXED + 8 * MB) + ((size_t)grp * 16 + lr) * 128 + h * 16;
#pragma unroll
        for (int r = 0; r < 16; r += 4) { *(int4*)(eo + r) = make_int4(ex[r], ex[r + 1], ex[r + 2], ex[r + 3]);
            *(f32x4*)(go + r) = (f32x4){ts[r] * inv, ts[r + 1] * inv, ts[r + 2] * inv, ts[r + 3] * inv}; }
    }
    __builtin_amdgcn_wave_barrier();
}
__device__ void phase_peer_topk(const Params& p, unsigned char* shm) {
    const int tid = otid(), wv = tid >> 6, h = blockIdx.x & 7, slot = blockIdx.x >> 3, nslot = gridDim.x >> 3;
    if (slot >= nslot) return;
    { const bf16_t* sk = (const bf16_t*)(p.ws + WS_SK) + (size_t)h * 2 * 128 * 128; bf16_t* sk_s = (bf16_t*)shm;
      for (int c = tid; c < 4096; c += NTHR) { const int row = c >> 4, part = c & 15; *(u32x4*)(sk_s + row * 136 + part * 8) = *(const u32x4*)(sk + (size_t)row * 128 + part * 8); }
      if (tid < 52) shm[69632 + 8 * 4096 + tid] = c_stair[tid]; }
    __syncthreads();
    bf16x8 qn[4];
    { const int lane = tid & 63, g = lane >> 4, lr = lane & 15; const int grp0 = slot * 8 + wv;
      const bf16_t* q0 = (const bf16_t*)(p.ws + WS_PROJ) + ((size_t)(grp0 < 1024 ? grp0 : 0) * 16 + lr) * 2048 + h * 256;
#pragma unroll
      for (int ks = 0; ks < 4; ++ks) qn[ks] = *(const bf16x8*)(q0 + ks * 32 + g * 8); }
    for (int grp = slot * 8 + wv; grp < 1024; grp += nslot * 8) { const int gnx = grp + nslot * 8; peer_topk_task(p, shm, grp, h, gnx < 1024 ? gnx : -1, qn); }
}

__device__ __forceinline__ void pg_load(const unsigned char* U, const unsigned char* V, int esel, int lbase, int lane, u32x4 (&ur)[4], u32x4 (&vr)[4]) {
#pragma unroll
    for (int k = 0; k < 4; ++k) { const int id = __builtin_amdgcn_readlane(esel, lbase + k); ur[k] = *(const u32x4*)(U + (size_t)id * 1024 + lane * 16); }
#pragma unroll
    for (int k = 0; k < 4; ++k) { const int id = __builtin_amdgcn_readlane(esel, lbase + k); vr[k] = *(const u32x4*)(V + (size_t)id * 1024 + lane * 16); }
}
typedef float f32x2 __attribute__((ext_vector_type(2)));
__device__ __forceinline__ void fp8x16_pk(const u32x4 w, f32x2* f) {
#pragma unroll
    for (int q = 0; q < 4; ++q) { f[q * 2] = __builtin_amdgcn_cvt_pk_f32_fp8((int)w[q], false); f[q * 2 + 1] = __builtin_amdgcn_cvt_pk_f32_fp8((int)w[q], true); }
}
__device__ __forceinline__ void fp8x16(const u32x4 w, float* f) {
#pragma unroll
    for (int q = 0; q < 4; ++q) { const auto lo = __builtin_amdgcn_cvt_pk_f32_fp8((int)w[q], false); const auto hi = __builtin_amdgcn_cvt_pk_f32_fp8((int)w[q], true);
        f[q * 4] = lo[0]; f[q * 4 + 1] = lo[1]; f[q * 4 + 2] = hi[0]; f[q * 4 + 3] = hi[1]; }
}
__device__ __forceinline__ void pg_comp(const u32x4 (&ur)[4], const u32x4 (&vr)[4], const float* xf, float* acc, float gsel, int lbase, int lane) {
    const bool b5 = lane & 32, b4 = lane & 16;
    const int kmine = ((lane >> 5) & 1) * 2 + ((lane >> 4) & 1);
    float d[4];
#pragma unroll
    for (int k = 0; k < 4; ++k) { float uf[16]; fp8x16(ur[k], uf); float s = 0.f;
#pragma unroll
        for (int i = 0; i < 16; ++i) s += uf[i] * xf[i];
        d[k] = s; }
    float r2[2], r1;
#pragma unroll
    for (int i = 0; i < 2; ++i) { const float a = b5 ? d[i + 2] : d[i], bb = b5 ? d[i] : d[i + 2]; r2[i] = a + __shfl_xor(bb, 32); }
    { const float a = b4 ? r2[1] : r2[0], bb = b4 ? r2[0] : r2[1]; r1 = a + __shfl_xor(bb, 16); }
    r1 += __shfl_xor(r1, 8); r1 += __shfl_xor(r1, 4); r1 += __shfl_xor(r1, 2); r1 += __shfl_xor(r1, 1);
    r1 *= (1.0f / 256.0f);
    const float gt = __shfl(gsel, lbase + kmine);
    const float wgt = gt * gelu_erf(r1) * (1.0f / 64.0f);
#pragma unroll
    for (int k = 0; k < 4; ++k) { const float wk = __int_as_float(__builtin_amdgcn_readlane(__float_as_int(wgt), ((k >> 1) & 1) * 32 + (k & 1) * 16));
        float vf[16]; fp8x16(vr[k], vf);
#pragma unroll
        for (int i = 0; i < 16; ++i) acc[i] += wk * vf[i]; }
}
__device__ void phase_peer_gather(const Params& p, float* dst) {
    const int lane = otid() & 63, wg = blockIdx.x * 8 + (otid() >> 6), nw = gridDim.x * 8;
    const unsigned char* U = p.ws + WS_U; const unsigned char* V = p.ws + WS_V;
    const bf16_t* xn = (const bf16_t*)(p.ws + WS_XN);
    const int* eid = (const int*)(p.ws + WS_MIXED); const float* gate = (const float*)(p.ws + WS_MIXED + 8 * MB);
    for (int tok = wg; tok < T_; tok += nw) {
        float xf[16];
        { const u32x4* xp = (const u32x4*)(xn + (size_t)tok * 1024 + lane * 16); unpack8(xp[0], xf); unpack8(xp[1], xf + 8); }
        const int e0 = eid[(size_t)tok * 128 + lane], e1 = eid[(size_t)tok * 128 + 64 + lane];
        const float g0 = gate[(size_t)tok * 128 + lane], g1 = gate[(size_t)tok * 128 + 64 + lane];
        float acc[16];
#pragma unroll
        for (int i = 0; i < 16; ++i) acc[i] = 0.f;
        u32x4 ua[4], va[4], ub[4], vb[4];
        pg_load(U, V, e0, 0, lane, ua, va);
#pragma unroll 1
        for (int bi = 0; bi < 32; bi += 2) {
            pg_load(U, V, (bi + 1 < 16) ? e0 : e1, ((bi + 1) & 15) * 4, lane, ub, vb);
            pg_comp(ua, va, xf, acc, (bi < 16) ? g0 : g1, (bi & 15) * 4, lane);
            if (bi + 2 < 32) pg_load(U, V, (bi + 2 < 16) ? e0 : e1, ((bi + 2) & 15) * 4, lane, ua, va);
            pg_comp(ub, vb, xf, acc, (bi + 1 < 16) ? g0 : g1, ((bi + 1) & 15) * 4, lane);
        }
        const float* op = p.out + (size_t)tok * 1024 + lane * 16; float* dp = dst + (size_t)tok * 1024 + lane * 16;
#pragma unroll
        for (int q4 = 0; q4 < 4; ++q4) { f32x4 o = *(const f32x4*)(op + q4 * 4);
            o[0] += acc[q4 * 4]; o[1] += acc[q4 * 4 + 1]; o[2] += acc[q4 * 4 + 2]; o[3] += acc[q4 * 4 + 3]; *(f32x4*)(dp + q4 * 4) = o; }
    }
}

__device__ __forceinline__ void pu_compute(const u32x4 (&ur)[8], const u32x4 xa, const u32x4 xb, float gs0, float gs1, float gs2, float gs3, float gs4, float gs5, float gs6, float gs7, int pos0, int pos1, int pos2, int pos3, int pos4, int pos5, int pos6, int pos7, float* wts, int lane) {
    const bool b5 = lane & 32, b4 = lane & 16, b3 = lane & 8;
    float xf[16]; unpack8(xa, xf); unpack8(xb, xf + 8);
    float d[8];
#pragma unroll
    for (int k = 0; k < 8; ++k) { float uf[16]; fp8x16(ur[k], uf); float sacc = 0.f;
#pragma unroll
        for (int i = 0; i < 16; ++i) sacc += uf[i] * xf[i];
        d[k] = sacc; }
    float r4[4], r2[2], r1;
#pragma unroll
    for (int i = 0; i < 4; ++i) { const float a = b5 ? d[i + 4] : d[i], bb = b5 ? d[i] : d[i + 4]; r4[i] = a + __shfl_xor(bb, 32); }
#pragma unroll
    for (int i = 0; i < 2; ++i) { const float a = b4 ? r4[i + 2] : r4[i], bb = b4 ? r4[i] : r4[i + 2]; r2[i] = a + __shfl_xor(bb, 16); }
    { const float a = b3 ? r2[1] : r2[0], bb = b3 ? r2[0] : r2[1]; r1 = a + __shfl_xor(bb, 8); }
    r1 += __shfl_xor(r1, 4); r1 += __shfl_xor(r1, 2); r1 += __shfl_xor(r1, 1);
    r1 *= (1.0f / 256.0f);
    const float gt = b5 ? (b4 ? (b3 ? gs7 : gs6) : (b3 ? gs5 : gs4)) : (b4 ? (b3 ? gs3 : gs2) : (b3 ? gs1 : gs0));
    const int ps = b5 ? (b4 ? (b3 ? pos7 : pos6) : (b3 ? pos5 : pos4)) : (b4 ? (b3 ? pos3 : pos2) : (b3 ? pos1 : pos0));
    const float w = gt * gelu_erf(r1) * (1.0f / 64.0f);
    if ((lane & 7) == 0 && ps >= 0) wts[ps] = w;
}
__device__ void phase_peer_u(const Params& p) {
    const int tid = otid(), lane = tid & 63, wv = tid >> 6;
    int bid = blockIdx.x; asm volatile("" : "+s"(bid));
    const int xs = bid & 7, slot = bid >> 3, nslot = gridDim.x >> 3;
    if (slot >= nslot) return;
    const int nwx = nslot * 8;
    const unsigned char* U = p.ws + WS_U; const bf16_t* xn = (const bf16_t*)(p.ws + WS_XN);
    const int* eid = (const int*)(p.ws + WS_MIXED); const float* gate = (const float*)(p.ws + WS_MIXED + 8 * MB);
    float* wts = (float*)(p.ws + WS_PROJ);
    int ntok = slot * 8 + wv, ctok = -1;
    int ne0 = -1, ne1 = -1, ce0 = -1, ce1 = -1; float ng0 = 0.f, ng1 = 0.f, cg0 = 0.f, cg1 = 0.f; u32x4 nxa = {0u, 0u, 0u, 0u}, nxb = nxa, cxa = nxa, cxb = nxa;
    unsigned long long m0 = 0ull, m1 = 0ull;
#define PU_LOADTOK() do { if (ntok < T_) { ne0 = eid[(size_t)ntok * 128 + lane]; ne1 = eid[(size_t)ntok * 128 + 64 + lane]; ng0 = gate[(size_t)ntok * 128 + lane]; ng1 = gate[(size_t)ntok * 128 + 64 + lane]; \
            const u32x4* xp_ = (const u32x4*)(xn + (size_t)ntok * 1024 + lane * 16); nxa = xp_[0]; nxb = xp_[1]; } } while (0)
#define PU_POP(I_, G_, P_) do { \
            if (m0) { const int l = __builtin_ctzll(m0); m0 &= m0 - 1ull; I_ = __builtin_amdgcn_readlane(ce0, l); G_ = __int_as_float(__builtin_amdgcn_readlane(__float_as_int(cg0), l)); P_ = ctok * 128 + l; last_ = I_; } \
            else if (m1) { const int l = __builtin_ctzll(m1); m1 &= m1 - 1ull; I_ = __builtin_amdgcn_readlane(ce1, l); G_ = __int_as_float(__builtin_amdgcn_readlane(__float_as_int(cg1), l)); P_ = ctok * 128 + 64 + l; last_ = I_; } \
            else { I_ = last_; G_ = 0.f; P_ = -1; } } while (0)
#define PU_NEXT(HAS, ID, GS, POS, XA, XB) do { HAS = true; \
        while ((m0 | m1) == 0ull) { if (ntok >= T_) { HAS = false; break; } \
            ctok = ntok; ce0 = ne0; ce1 = ne1; cg0 = ng0; cg1 = ng1; cxa = nxa; cxb = nxb; \
            m0 = __ballot((ce0 >> 11) == xs); m1 = __ballot((ce1 >> 11) == xs); ntok += nwx; PU_LOADTOK(); } \
        if (HAS) { int last_ = 0; \
            PU_POP(ID##0, GS##0, POS##0); PU_POP(ID##1, GS##1, POS##1); PU_POP(ID##2, GS##2, POS##2); PU_POP(ID##3, GS##3, POS##3); PU_POP(ID##4, GS##4, POS##4); PU_POP(ID##5, GS##5, POS##5); PU_POP(ID##6, GS##6, POS##6); PU_POP(ID##7, GS##7, POS##7); \
          XA = cxa; XB = cxb; } } while (0)
#define PU_ROWS(ID, UR) do { UR[0] = *(const u32x4*)(U + (size_t)ID##0 * 1024 + lane * 16); UR[1] = *(const u32x4*)(U + (size_t)ID##1 * 1024 + lane * 16); UR[2] = *(const u32x4*)(U + (size_t)ID##2 * 1024 + lane * 16); UR[3] = *(const u32x4*)(U + (size_t)ID##3 * 1024 + lane * 16); UR[4] = *(const u32x4*)(U + (size_t)ID##4 * 1024 + lane * 16); UR[5] = *(const u32x4*)(U + (size_t)ID##5 * 1024 + lane * 16); UR[6] = *(const u32x4*)(U + (size_t)ID##6 * 1024 + lane * 16); UR[7] = *(const u32x4*)(U + (size_t)ID##7 * 1024 + lane * 16); } while (0)
    PU_LOADTOK();
    int ida0 = 0, idb0 = 0, posa0 = -1, posb0 = -1, ida1 = 0, idb1 = 0, posa1 = -1, posb1 = -1, ida2 = 0, idb2 = 0, posa2 = -1, posb2 = -1, ida3 = 0, idb3 = 0, posa3 = -1, posb3 = -1, ida4 = 0, idb4 = 0, posa4 = -1, posb4 = -1, ida5 = 0, idb5 = 0, posa5 = -1, posb5 = -1, ida6 = 0, idb6 = 0, posa6 = -1, posb6 = -1, ida7 = 0, idb7 = 0, posa7 = -1, posb7 = -1;
    float gsa0 = 0.f, gsb0 = 0.f, gsa1 = 0.f, gsb1 = 0.f, gsa2 = 0.f, gsb2 = 0.f, gsa3 = 0.f, gsb3 = 0.f, gsa4 = 0.f, gsb4 = 0.f, gsa5 = 0.f, gsb5 = 0.f, gsa6 = 0.f, gsb6 = 0.f, gsa7 = 0.f, gsb7 = 0.f; u32x4 xaa = cxa, xab = cxa, xba = cxa, xbb = cxa, ua[8], ub[8];
    bool ha, hb;
    PU_NEXT(ha, ida, gsa, posa, xaa, xab);
    if (ha) PU_ROWS(ida, ua);
    while (ha) {
        PU_NEXT(hb, idb, gsb, posb, xba, xbb);
        if (hb) PU_ROWS(idb, ub);
        pu_compute(ua, xaa, xab, gsa0, gsa1, gsa2, gsa3, gsa4, gsa5, gsa6, gsa7, posa0, posa1, posa2, posa3, posa4, posa5, posa6, posa7, wts, lane);
        if (!hb) break;
        PU_NEXT(ha, ida, gsa, posa, xaa, xab);
        if (ha) PU_ROWS(ida, ua);
        pu_compute(ub, xba, xbb, gsb0, gsb1, gsb2, gsb3, gsb4, gsb5, gsb6, gsb7, posb0, posb1, posb2, posb3, posb4, posb5, posb6, posb7, wts, lane);
    }
#undef PU_LOADTOK
#undef PU_NEXT
#undef PU_POP
#undef PU_ROWS
}
__device__ __forceinline__ void peer_sorted_token(const Params& p, int tok, int lane, int& e0, int& e1, float& g0, float& g1) {
    const int* eid = (const int*)(p.ws + WS_MIXED); const float* gate = (const float*)(p.ws + WS_MIXED + 8 * MB);
    e0 = eid[(size_t)tok * 128 + lane]; e1 = eid[(size_t)tok * 128 + 64 + lane];
    g0 = gate[(size_t)tok * 128 + lane]; g1 = gate[(size_t)tok * 128 + 64 + lane];
    unsigned k0 = ((unsigned)e0 << 7) | (unsigned)lane, k1 = ((unsigned)e1 << 7) | (unsigned)(64 + lane);
#pragma unroll
    for (int k = 2; k <= 128; k <<= 1) {
#pragma unroll
        for (int j = k >> 1; j >= 1; j >>= 1) {
            if (j == 64) { const unsigned lo = min(k0, k1), hi = max(k0, k1); k0 = lo; k1 = hi; }
            else { const unsigned o0 = (unsigned)__shfl_xor((int)k0, j), o1 = (unsigned)__shfl_xor((int)k1, j);
                const bool lower = (lane & j) == 0, up0 = (lane & k) == 0, up1 = ((64 + lane) & k) == 0;
                k0 = (lower == up0) ? min(k0, o0) : max(k0, o0); k1 = (lower == up1) ? min(k1, o1) : max(k1, o1); }
        }
    }
    const int s0 = (int)(k0 & 127u), s1 = (int)(k1 & 127u);
    const float ga0 = __shfl(g0, s0 & 63), gb0 = __shfl(g1, s0 & 63), ga1 = __shfl(g0, s1 & 63), gb1 = __shfl(g1, s1 & 63);
    e0 = (int)(k0 >> 7); e1 = (int)(k1 >> 7); g0 = (s0 < 64) ? ga0 : gb0; g1 = (s1 < 64) ? ga1 : gb1;
    int* eidw = (int*)(p.ws + WS_MIXED); eidw[(size_t)tok * 128 + lane] = e0; eidw[(size_t)tok * 128 + 64 + lane] = e1;
}
__device__ void phase_peer_u_tok(const Params& p) {
    const int lane = otid() & 63, wg = blockIdx.x * 8 + (otid() >> 6), nw = gridDim.x * 8;
    const unsigned char* U = p.ws + WS_U; const bf16_t* xn = (const bf16_t*)(p.ws + WS_XN);
    float* wts = (float*)(p.ws + WS_PROJ);
    const bool b5 = lane & 32, b4 = lane & 16, b3 = lane & 8;
    const int kmine = ((lane >> 5) & 1) * 4 + ((lane >> 4) & 1) * 2 + ((lane >> 3) & 1);
    int rnd = 0;
    for (int tbase = wg; tbase < T_; tbase += 4 * nw, ++rnd) {
        const int rev = (rnd & 1) ? 15 : 0;
        const bool has0 = tbase + 0 * nw < T_; const int tok0 = has0 ? tbase + 0 * nw : tbase;
        const bool has1 = tbase + 1 * nw < T_; const int tok1 = has1 ? tbase + 1 * nw : tbase;
        const bool has2 = tbase + 2 * nw < T_; const int tok2 = has2 ? tbase + 2 * nw : tbase;
        const bool has3 = tbase + 3 * nw < T_; const int tok3 = has3 ? tbase + 3 * nw : tbase;
        u32x4 xa0, xb0; { const u32x4* xp = (const u32x4*)(xn + (size_t)tok0 * 1024 + lane * 16); xa0 = xp[0]; xb0 = xp[1]; }
        u32x4 xa1, xb1; { const u32x4* xp = (const u32x4*)(xn + (size_t)tok1 * 1024 + lane * 16); xa1 = xp[0]; xb1 = xp[1]; }
        u32x4 xa2, xb2; { const u32x4* xp = (const u32x4*)(xn + (size_t)tok2 * 1024 + lane * 16); xa2 = xp[0]; xb2 = xp[1]; }
        u32x4 xa3, xb3; { const u32x4* xp = (const u32x4*)(xn + (size_t)tok3 * 1024 + lane * 16); xa3 = xp[0]; xb3 = xp[1]; }
        int e00, e01; float g00, g01; peer_sorted_token(p, tok0, lane, e00, e01, g00, g01);
        int e10, e11; float g10, g11; if (has1) peer_sorted_token(p, tok1, lane, e10, e11, g10, g11); else { e10 = e00; e11 = e01; g10 = 0.f; g11 = 0.f; }
        int e20, e21; float g20, g21; if (has2) peer_sorted_token(p, tok2, lane, e20, e21, g20, g21); else { e20 = e00; e21 = e01; g20 = 0.f; g21 = 0.f; }
        int e30, e31; float g30, g31; if (has3) peer_sorted_token(p, tok3, lane, e30, e31, g30, g31); else { e30 = e00; e31 = e01; g30 = 0.f; g31 = 0.f; }
        u32x4 ua[8], ub[8];
#define PUT_LD(bi_, U_, E0_, E1_) do { const int es_ = ((bi_) < 8) ? E0_ : E1_; _Pragma("unroll") for (int k = 0; k < 8; ++k) { const int id = __builtin_amdgcn_readlane(es_, ((bi_) & 7) * 8 + k); U_[k] = *(const u32x4*)(U + (size_t)id * 1024 + lane * 16); } } while (0)
#define PUT_CP(bi_, U_, XA_, XB_, G0_, G1_, TOK_, ST_) do { float xf_[16]; unpack8(XA_, xf_); unpack8(XB_, xf_ + 8); f32x2 x2_[8]; _Pragma("unroll") for (int i = 0; i < 8; ++i) x2_[i] = (f32x2){xf_[2 * i], xf_[2 * i + 1]}; float d[8]; _Pragma("unroll") for (int k = 0; k < 8; ++k) { f32x2 uf[8]; fp8x16_pk(U_[k], uf); f32x2 sacc = uf[0] * x2_[0]; _Pragma("unroll") for (int i = 1; i < 8; ++i) sacc = __builtin_elementwise_fma(uf[i], x2_[i], sacc); d[k] = sacc[0] + sacc[1]; } \
            float r4[4], r2[2], r1; \
            _Pragma("unroll") for (int i = 0; i < 4; ++i) { const float a = b5 ? d[i + 4] : d[i], bb = b5 ? d[i] : d[i + 4]; r4[i] = a + __shfl_xor(bb, 32); } \
            _Pragma("unroll") for (int i = 0; i < 2; ++i) { const float a = b4 ? r4[i + 2] : r4[i], bb = b4 ? r4[i] : r4[i + 2]; r2[i] = a + __shfl_xor(bb, 16); } \
            { const float a = b3 ? r2[1] : r2[0], bb = b3 ? r2[0] : r2[1]; r1 = a + __shfl_xor(bb, 8); } \
            r1 += __shfl_xor(r1, 4); r1 += __shfl_xor(r1, 2); r1 += __shfl_xor(r1, 1); r1 *= (1.0f / 256.0f); \
            const float gt = __shfl(((bi_) < 8) ? G0_ : G1_, ((bi_) & 7) * 8 + kmine); \
            if ((lane & 7) == 0 && (ST_)) wts[(size_t)(TOK_) * 128 + (bi_) * 8 + kmine] = gt * gelu_erf(r1) * (1.0f / 64.0f); } while (0)
        PUT_LD(0 ^ rev, ua, e00, e01);
#pragma unroll 1
        for (int bi = 0; bi < 16; ++bi) {
            PUT_LD(bi ^ rev, ub, e10, e11);
            PUT_CP(bi ^ rev, ua, xa0, xb0, g00, g01, tok0, has0);
            PUT_LD(bi ^ rev, ua, e20, e21);
            PUT_CP(bi ^ rev, ub, xa1, xb1, g10, g11, tok1, has1);
            PUT_LD(bi ^ rev, ub, e30, e31);
            PUT_CP(bi ^ rev, ua, xa2, xb2, g20, g21, tok2, has2);
            if (bi + 1 < 16) PUT_LD((bi + 1) ^ rev, ua, e00, e01);
            PUT_CP(bi ^ rev, ub, xa3, xb3, g30, g31, tok3, has3);
        }
#undef PUT_LD
#undef PUT_CP
    }
}
__device__ void phase_peer_v(const Params& p) {
    const int lane = otid() & 63, wg = blockIdx.x * 8 + (otid() >> 6), nw = gridDim.x * 8;
    const unsigned char* V = p.ws + WS_V;
    const int* eid = (const int*)(p.ws + WS_MIXED); const float* wts = (const float*)(p.ws + WS_PROJ);
    int rnd = 0;
    for (int tbase = wg; tbase < T_; tbase += 4 * nw, ++rnd) {
        const int rev = (rnd & 1) ? 31 : 0;
        const bool has0 = tbase + 0 * nw < T_; const int tok0 = has0 ? tbase + 0 * nw : tbase;
        const bool has1 = tbase + 1 * nw < T_; const int tok1 = has1 ? tbase + 1 * nw : tbase;
        const bool has2 = tbase + 2 * nw < T_; const int tok2 = has2 ? tbase + 2 * nw : tbase;
        const bool has3 = tbase + 3 * nw < T_; const int tok3 = has3 ? tbase + 3 * nw : tbase;
        const int e00 = eid[(size_t)tok0 * 128 + lane], e01 = eid[(size_t)tok0 * 128 + 64 + lane]; const float w00 = wts[(size_t)tok0 * 128 + lane], w01 = wts[(size_t)tok0 * 128 + 64 + lane];
        f32x2 acc0[8];
#pragma unroll
        for (int i = 0; i < 8; ++i) acc0[i] = (f32x2){0.f, 0.f};
        const int e10 = eid[(size_t)tok1 * 128 + lane], e11 = eid[(size_t)tok1 * 128 + 64 + lane]; const float w10 = wts[(size_t)tok1 * 128 + lane], w11 = wts[(size_t)tok1 * 128 + 64 + lane];
        f32x2 acc1[8];
#pragma unroll
        for (int i = 0; i < 8; ++i) acc1[i] = (f32x2){0.f, 0.f};
        const int e20 = eid[(size_t)tok2 * 128 + lane], e21 = eid[(size_t)tok2 * 128 + 64 + lane]; const float w20 = wts[(size_t)tok2 * 128 + lane], w21 = wts[(size_t)tok2 * 128 + 64 + lane];
        f32x2 acc2[8];
#pragma unroll
        for (int i = 0; i < 8; ++i) acc2[i] = (f32x2){0.f, 0.f};
        const int e30 = eid[(size_t)tok3 * 128 + lane], e31 = eid[(size_t)tok3 * 128 + 64 + lane]; const float w30 = wts[(size_t)tok3 * 128 + lane], w31 = wts[(size_t)tok3 * 128 + 64 + lane];
        f32x2 acc3[8];
#pragma unroll
        for (int i = 0; i < 8; ++i) acc3[i] = (f32x2){0.f, 0.f};
        u32x4 va[4], vb[4];
#define PV_LD(bi_, V_, E0_, E1_) do { const int es_ = ((bi_) < 16) ? E0_ : E1_; _Pragma("unroll") for (int k = 0; k < 4; ++k) { const int id = __builtin_amdgcn_readlane(es_, ((bi_) & 15) * 4 + k); V_[k] = *(const u32x4*)(V + (size_t)id * 1024 + lane * 16); } } while (0)
#define PV_CP(bi_, V_, W0_, W1_, ACC_) do { const float ws_ = ((bi_) < 16) ? W0_ : W1_; _Pragma("unroll") for (int k = 0; k < 4; ++k) { const float wk = __int_as_float(__builtin_amdgcn_readlane(__float_as_int(ws_), ((bi_) & 15) * 4 + k)); \
            f32x2 vf[8]; fp8x16_pk(V_[k], vf); const f32x2 wk2 = (f32x2){wk, wk}; _Pragma("unroll") for (int i = 0; i < 8; ++i) ACC_[i] = __builtin_elementwise_fma(vf[i], wk2, ACC_[i]); } } while (0)
        PV_LD(0 ^ rev, va, e00, e01);
#pragma unroll 1
        for (int bi = 0; bi < 32; ++bi) {
            PV_LD(bi ^ rev, vb, e10, e11);
            PV_CP(bi ^ rev, va, w00, w01, acc0);
            PV_LD(bi ^ rev, va, e20, e21);
            PV_CP(bi ^ rev, vb, w10, w11, acc1);
            PV_LD(bi ^ rev, vb, e30, e31);
            PV_CP(bi ^ rev, va, w20, w21, acc2);
            if (bi + 1 < 32) PV_LD((bi + 1) ^ rev, va, e00, e01);
            PV_CP(bi ^ rev, vb, w30, w31, acc3);
        }
#undef PV_LD
#undef PV_CP
        if (has0) { float* op = p.out + (size_t)tok0 * 1024 + lane * 16;
#pragma unroll
          for (int q4 = 0; q4 < 4; ++q4) { f32x4 o = *(const f32x4*)(op + q4 * 4);
              o[0] += acc0[q4 * 2][0]; o[1] += acc0[q4 * 2][1]; o[2] += acc0[q4 * 2 + 1][0]; o[3] += acc0[q4 * 2 + 1][1]; *(f32x4*)(op + q4 * 4) = o; } }
        if (has1) { float* op = p.out + (size_t)tok1 * 1024 + lane * 16;
#pragma unroll
          for (int q4 = 0; q4 < 4; ++q4) { f32x4 o = *(const f32x4*)(op + q4 * 4);
              o[0] += acc1[q4 * 2][0]; o[1] += acc1[q4 * 2][1]; o[2] += acc1[q4 * 2 + 1][0]; o[3] += acc1[q4 * 2 + 1][1]; *(f32x4*)(op + q4 * 4) = o; } }
        if (has2) { float* op = p.out + (size_t)tok2 * 1024 + lane * 16;
#pragma unroll
          for (int q4 = 0; q4 < 4; ++q4) { f32x4 o = *(const f32x4*)(op + q4 * 4);
              o[0] += acc2[q4 * 2][0]; o[1] += acc2[q4 * 2][1]; o[2] += acc2[q4 * 2 + 1][0]; o[3] += acc2[q4 * 2 + 1][1]; *(f32x4*)(op + q4 * 4) = o; } }
        if (has3) { float* op = p.out + (size_t)tok3 * 1024 + lane * 16;
#pragma unroll
          for (int q4 = 0; q4 < 4; ++q4) { f32x4 o = *(const f32x4*)(op + q4 * 4);
              o[0] += acc3[q4 * 2][0]; o[1] += acc3[q4 * 2][1]; o[2] += acc3[q4 * 2 + 1][0]; o[3] += acc3[q4 * 2 + 1][1]; *(f32x4*)(op + q4 * 4) = o; } }
    }
}

constexpr size_t WS_BAR = 239 * MB;
#define XB_TMO      128
#define XB_XCNT(j)  (256  + 64 * (j))
#define XB_XSUB(j)  (1280 + 64 * (j))
#define XB_XGEN(j)  (2304 + 64 * (j))
#define XB_TOP      3328
#define XB_TOPGEN   3392
#define XCD_BAR_WORDS 3456
#define XB_SPIN_CAP (1u << 18)
__device__ __forceinline__ unsigned xb_ld(unsigned* p)              { return __hip_atomic_load(p, __ATOMIC_RELAXED, __HIP_MEMORY_SCOPE_AGENT); }
__device__ __forceinline__ unsigned xb_add(unsigned* p, unsigned v) { return __hip_atomic_fetch_add(p, v, __ATOMIC_RELAXED, __HIP_MEMORY_SCOPE_AGENT); }
__device__ __forceinline__ unsigned xb_xcc_id() { return (unsigned)__builtin_amdgcn_s_getreg((3 << 11) | 20) & 0xFu; }
#define XB_SPIN(cond, bar) do { unsigned _sp = 0; while (cond) { __builtin_amdgcn_s_sleep(1); \
    if ((++_sp & 255u) == 0u) { if (xb_ld(&(bar)[XB_TMO])) break; if (_sp > XB_SPIN_CAP) { atomicAdd(&(bar)[XB_TMO], 1u); break; } } } } while (0)
struct XcdBarrier { unsigned* bar; unsigned x; volatile LAS unsigned* st; };
__device__ __forceinline__ XcdBarrier xcd_barrier_post(unsigned* bar, volatile LAS unsigned* st) {
    XcdBarrier b; b.bar = bar; b.x = xb_xcc_id(); b.st = st;
    if (threadIdx.x == 0) (void)xb_add(&bar[XB_XCNT(b.x)], 1u);
    return b;
}
__device__ __forceinline__ void xcd_barrier_complete(unsigned* bar, unsigned x, unsigned& nloc, unsigned& nx) {
    const unsigned G = gridDim.x * gridDim.y * gridDim.z;
    unsigned sum, cnt, mine, sp = 0u;
    for (;;) {
        sum = 0u; cnt = 0u; mine = 0u;
#pragma unroll
        for (unsigned j = 0; j < 16; ++j) { const unsigned c = xb_ld(&bar[XB_XCNT(j)]); sum += c; cnt += (c > 0u) ? 1u : 0u; mine = (j == x) ? c : mine; }
        if (sum == G) break;
        __builtin_amdgcn_s_sleep(1);
        if ((++sp & 255u) == 0u) { if (xb_ld(&bar[XB_TMO])) break; if (sp > XB_SPIN_CAP) { atomicAdd(&bar[XB_TMO], 1u); break; } }
    }
    nloc = mine > 0u ? mine : 1u; nx = cnt > 0u ? cnt : 1u;
}
__device__ __forceinline__ void xcd_barrier(const XcdBarrier& b) {
    asm volatile("s_waitcnt vmcnt(0)" ::: "memory");
    __syncthreads();
    if (threadIdx.x == 0) {
        unsigned* bar = b.bar;
        __builtin_amdgcn_s_waitcnt(0);
        unsigned nloc = b.st[0], nx = b.st[1];
        if (nloc == 0u) { xcd_barrier_complete(bar, b.x, nloc, nx); b.st[0] = nloc; b.st[1] = nx; }
        const unsigned old = xb_add(&bar[XB_XSUB(b.x)], 1u);
        const unsigned gen = old / nloc;
        if (old + 1u == (gen + 1u) * nloc) {
            __builtin_amdgcn_fence(__ATOMIC_RELEASE, "agent");
            asm volatile("s_waitcnt vmcnt(0)" ::: "memory");
            const unsigned og = xb_add(&bar[XB_TOP], 1u);
            const unsigned tg = og / nx;
            if (og + 1u == (tg + 1u) * nx) xb_add(&bar[XB_TOPGEN], 1u);
            else XB_SPIN(xb_ld(&bar[XB_TOPGEN]) == tg, bar);
            __builtin_amdgcn_fence(__ATOMIC_ACQUIRE, "agent");
            xb_add(&bar[XB_XGEN(b.x)], 1u);
            asm volatile("s_waitcnt vmcnt(0)" ::: "memory");
        } else {
            XB_SPIN(xb_ld(&bar[XB_XGEN(b.x)]) == gen, bar);
            __builtin_amdgcn_fence(__ATOMIC_ACQUIRE, "agent");
            asm volatile("s_waitcnt vmcnt(0)" ::: "memory");
        }
    }
    __syncthreads();
}
__device__ __forceinline__ void seam(const XcdBarrier& xb, int k) {
    asm volatile("" : "+s"(k));
    if (k < 0) cg::this_grid().sync();
    else xcd_barrier(xb);
}

__global__ void __launch_bounds__(NTHR, 2) fwd_kernel(Params p) {
    extern __shared__ __attribute__((aligned(16))) unsigned char shm[];
    __shared__ uint4 xb_words;
    if (threadIdx.x == 0) xb_words = make_uint4(0u, 0u, 0u, 0u);
    __syncthreads();
    const XcdBarrier xb = xcd_barrier_post((unsigned*)(p.ws + WS_BAR), (volatile LAS unsigned*)&xb_words);
#ifndef PH_MASK
#define PH_MASK 0x7ff
#endif
#define PH_ON(n) ((PH_MASK >> (n)) & 1)
#define PHASE(n) if (PH_ON(n) && (n) >= p.ph_lo && (n) < p.ph_hi && (((n) > p.ph_lo) ? (seam(xb, (n)), true) : true))
    PHASE(0) {
#pragma unroll 1
        for (int rep = 0; rep < REP0; ++rep) { if (rep) cg::this_grid().sync();   phase_prep(p, shm); } }
    PHASE(1) for (int rep = 0; rep < REPG; ++rep) { if (rep) cg::this_grid().sync();   pg8::Gemm gm{(const bf16_t*)(p.ws + WS_XN), (const bf16_t*)(p.ws + WS_WIN), T_, NPROJ, D_}; pg8::StaticOrder so; so.init(T_, NPROJ, gridDim.x, blockIdx.x);
               pg8::EpiBf16Out ep{(bf16_t*)(p.ws + WS_PROJ), NPROJ}; pg8::gemm_phase((LAS unsigned char*)shm, gm, so, ep); }
    PHASE(2) phase_mixprep(p, shm);
    PHASE(3) { gla_scan(p);
#pragma unroll 1
        for (int rep = 0; rep < REP3; ++rep) { if (rep) cg::this_grid().sync();   phase_moba(p, shm); } }
    PHASE(4) {
#pragma unroll 1
        for (int rep = 0; rep < REP4; ++rep) { if (rep) cg::this_grid().sync();   phase_gla_out(p); } }
    PHASE(5) for (int rep = 0; rep < REPG; ++rep) { if (rep) cg::this_grid().sync();   pg8::Gemm gm{(const bf16_t*)(p.ws + WS_MIXED), (const bf16_t*)(p.ws + WS_WOUT), T_, D_, D_}; pg8::StaticOrder so; so.init(T_, D_, gridDim.x, blockIdx.x);
               pg8::EpiResF32 ep{p.out, p.x, D_}; pg8::gemm_phase((LAS unsigned char*)shm, gm, so, ep); }
    PHASE(6) {
#pragma unroll 1
        for (int rep = 0; rep < REP4; ++rep) { if (rep) cg::this_grid().sync();   rmsnorm_rows<false>(p.out, p.norm2_w, (bf16_t*)(p.ws + WS_XN), nullptr, nullptr); } }
    PHASE(7) for (int rep = 0; rep < REPG; ++rep) { if (rep) cg::this_grid().sync();   pg8::Gemm gm{(const bf16_t*)(p.ws + WS_XN), (const bf16_t*)(p.ws + WS_WQ), T_, 2048, D_}; pg8::StaticOrder so; so.init(T_, 2048, gridDim.x, blockIdx.x);
               pg8::EpiBf16Out ep{(bf16_t*)(p.ws + WS_PROJ), 2048}; pg8::gemm_phase((LAS unsigned char*)shm, gm, so, ep); }
    PHASE(8) {
#pragma unroll 1
        for (int rep = 0; rep < REP8; ++rep) { if (rep) cg::this_grid().sync();   phase_peer_topk(p, shm); } }
#if SPLIT_GATHER
#if SPLIT_GATHER == 2
    PHASE(9) phase_peer_u_tok(p);
#else
    PHASE(9) phase_peer_u(p);
#endif
    PHASE(10) phase_peer_v(p);
#else
    PHASE(9) phase_peer_gather(p, p.out);
#endif
}

extern "C" void kernel_launch(void* const* d_in, const int* in_sizes, int n_in, void* d_out, int out_size, void* d_ws, size_t ws_size, hipStream_t stream) {
    static int grid = 0;
    if (grid == 0) {
        int dev = 0, cus = 0, per_cu = 0;
        (void)hipGetDevice(&dev);
        (void)hipDeviceGetAttribute(&cus, hipDeviceAttributeMultiprocessorCount, dev);
        if (hipFuncSetAttribute((const void*)fwd_kernel, hipFuncAttributeMaxDynamicSharedMemorySize, LDS_BYTES) != hipSuccess) fprintf(stderr, "hipFuncSetAttribute failed\n");
        (void)hipOccupancyMaxActiveBlocksPerMultiprocessor(&per_cu, (const void*)fwd_kernel, NTHR, LDS_BYTES);
        if (per_cu < 1) per_cu = 1;
        grid = cus * 1;
        (void)hipGetLastError();
        if (ws_size < WS_END) fprintf(stderr, "workspace too small: %zu\n", ws_size);
    }
    Params p{};
    p.x = (const float*)d_in[0]; p.norm1_w = (const float*)d_in[1]; p.w_in = (const float*)d_in[2]; p.w_alpha = (const float*)d_in[3]; p.b_alpha = (const float*)d_in[4];
    p.gla_onw = (const float*)d_in[5]; p.mqw = (const float*)d_in[6]; p.mkw = (const float*)d_in[7]; p.mix_scale = (const float*)d_in[8]; p.w_out = (const float*)d_in[9];
    p.norm2_w = (const float*)d_in[10]; p.w_query = (const float*)d_in[11]; p.subkeys = (const float*)d_in[12]; p.peer_u = (const float*)d_in[13]; p.peer_v = (const float*)d_in[14];
    p.out = (float*)d_out; p.ws = (unsigned char*)d_ws;
#if MEGA
    p.ph_lo = 0; p.ph_hi = 11;
    (void)hipMemsetAsync((unsigned char*)d_ws + WS_BAR, 0, 16384, stream);
    void* args[] = {&p};
    hipError_t e = hipLaunchCooperativeKernel((const void*)fwd_kernel, dim3(grid), dim3(NTHR), args, LDS_BYTES, stream);
    if (e != hipSuccess) fprintf(stderr, "cooperative launch failed: %s (grid %d)\n", hipGetErrorString(e), grid);
#else
    for (int ph = 0; ph < 10; ++ph) { p.ph_lo = ph; p.ph_hi = ph + 1; hipLaunchKernelGGL(fwd_kernel, dim3(grid), dim3(NTHR), LDS_BYTES, stream, p); }
#endif
}
```

```cpp
#include <hip/hip_runtime.h>
#include <hip/hip_cooperative_groups.h>
#include <cstdio>
namespace cg = cooperative_groups;

#define REP0 1
#ifndef SPLIT_GATHER
#define SPLIT_GATHER 2
#endif
#define REPG 1
#define REP4 1
#define REP3 1
#define REP8 1
#define REP9 1
#ifndef MEGA
#define MEGA 1
#endif

typedef unsigned short bf16_t;
typedef short bf16x8 __attribute__((ext_vector_type(8)));
typedef short bf16x4 __attribute__((ext_vector_type(4)));
typedef float f32x4 __attribute__((ext_vector_type(4)));
typedef unsigned u32x4 __attribute__((ext_vector_type(4)));
typedef unsigned u32x2 __attribute__((ext_vector_type(2)));
typedef int i32x4 __attribute__((ext_vector_type(4)));
#define LAS __attribute__((address_space(3)))

constexpr int T_ = 16384, D_ = 1024, S_ = 4096;
constexpr int NPROJ = 3072;
constexpr int C_GQ = 0, C_GK = 256, C_GV = 512, C_GG = 1024, C_MQ = 1536, C_MK = 2048, C_MV = 2560;
constexpr int WIN_LD = 3088;
constexpr float EPS_ = 1e-6f;
constexpr int LDS_BYTES = 131072;
constexpr int NTHR = 512;

constexpr size_t MB = 1024 * 1024;
constexpr size_t WS_WIN = 0, WS_WOUT = 6 * MB, WS_WQ = 8 * MB, WS_U = 12 * MB, WS_V = 44 * MB, WS_XN = 76 * MB,
                 WS_PROJ = 108 * MB, WS_MIXED = 204 * MB, WS_GR = 236 * MB, WS_DECAY = 237 * MB,
                 WS_ROPE = 237 * MB + 256 * 1024, WS_SK = 238 * MB + 256 * 1024, WS_END = 239 * MB;
constexpr size_t WS_WQ8 = WS_WIN, WS_SW = WS_WIN + 2 * MB, WS_SX = WS_WIN + 2 * MB + 65536, WS_XQ8 = WS_U + 16 * MB;
constexpr size_t OUT_GVT = 0, OUT_MVT = 16 * MB, OUT_KBAR = 32 * MB;

struct Params {
    const float *x, *norm1_w, *w_in, *w_alpha, *b_alpha, *gla_onw, *mqw, *mkw, *mix_scale, *w_out, *norm2_w, *w_query, *subkeys, *peer_u, *peer_v;
    float* out; unsigned char* ws; int ph_lo, ph_hi;
};

__device__ __forceinline__ bf16_t f2bf(float f) { unsigned u = __float_as_uint(f); u += 0x7FFFu + ((u >> 16) & 1u); return (bf16_t)(u >> 16); }
__device__ __forceinline__ float bf2f(bf16_t b) { return __uint_as_float(((unsigned)b) << 16); }
__device__ __forceinline__ unsigned pk2(float lo, float hi) { unsigned r; asm volatile("v_cvt_pk_bf16_f32 %0, %1, %2" : "=v"(r) : "v"(lo), "v"(hi)); return r; }
__device__ __forceinline__ float lo_f(unsigned w) { return __uint_as_float(w << 16); }
__device__ __forceinline__ float hi_f(unsigned w) { return __uint_as_float(w & 0xffff0000u); }
__device__ __forceinline__ void unpack8(const u32x4 w, float* f) { f[0] = lo_f(w.x); f[1] = hi_f(w.x); f[2] = lo_f(w.y); f[3] = hi_f(w.y); f[4] = lo_f(w.z); f[5] = hi_f(w.z); f[6] = lo_f(w.w); f[7] = hi_f(w.w); }
__device__ __forceinline__ float wave_sum(float v) { for (int o = 32; o > 0; o >>= 1) v += __shfl_xor(v, o); return v; }
__device__ __forceinline__ unsigned ordf(float f) { unsigned u = __float_as_uint(f); return (u & 0x80000000u) ? ~u : (u | 0x80000000u); }
__device__ __forceinline__ float unordf(unsigned o) { unsigned u = (o & 0x80000000u) ? (o & 0x7fffffffu) : ~o; return __uint_as_float(u); }
__device__ __forceinline__ bf16x8 as_bf16x8(u32x4 v) { union { u32x4 a; bf16x8 b; } t; t.a = v; return t.b; }
__device__ __forceinline__ bf16x8 as_bf16x8_2(u32x2 lo, u32x2 hi) { union { unsigned a[4]; bf16x8 b; } t; t.a[0] = lo.x; t.a[1] = lo.y; t.a[2] = hi.x; t.a[3] = hi.y; return t.b; }
__device__ __forceinline__ bf16x4 as_bf16x4(u32x2 v) { union { u32x2 a; bf16x4 b; } t; t.a = v; return t.b; }
__device__ __forceinline__ int otid() { int t = threadIdx.x; asm volatile("" : "+v"(t)); return t; }
__device__ __forceinline__ float gelu_erf(float v) {
    const float av = fabsf(v), t = __builtin_amdgcn_rcpf(av * 0.2316418882f + 1.0f);
    float q = t * 0.5307027145f + (-0.7265760135f); q = q * t + 0.7107068705f; q = q * t + (-0.142248368f); q = q * t + 0.127414796f; q = q * t;
    const float e = __builtin_amdgcn_exp2f((v * v) * (-0.72134752044f));
    const float m = v * (q * e);
    return v < 0.f ? m : v - m;
}
#define MFMA32(a, b, c) __builtin_amdgcn_mfma_f32_16x16x32_bf16((a), (b), (c), 0, 0, 0)
#define MFMA16(a, b, c) __builtin_amdgcn_mfma_f32_16x16x16bf16_1k((a), (b), (c), 0, 0, 0)

namespace pg8 {
constexpr int BM = 256, BK = 64, HALF = 128, HTB = HALF * BK * 2, NXCD = 8, WGM = 8;
__device__ __forceinline__ int lds_byte(int r, int c) { const int st = (r >> 4) * 2 + (c >> 5), rr = r & 15, cc = c & 31, ob = rr * 64 + cc * 2; return st * 1024 + (ob ^ (((ob >> 9) & 1) << 5)); }
__device__ __forceinline__ void stage_rc(int b, int& R, int& C) { const int st = b / 1024, sb = b % 1024, swz = sb ^ (((sb >> 9) & 1) << 5); R = (st >> 1) * 16 + swz / 64; C = (st & 1) * 32 + (swz % 64) / 2; }
__device__ __forceinline__ int perm32(int rho) { const int n = rho >> 4, i = rho & 15; return 8 * (i >> 2) + 4 * n + (i & 3); }
struct Unit { int pm, pn; };
struct Gemm { const bf16_t* A; const bf16_t* Bt; int M, N, K; };
struct StaticOrder {
    int nM, nN, nwg, G, c;
    __device__ void init(int M, int N, int G_, int c_) { nM = M / BM; nN = N / BM; nwg = nM * nN; G = G_; c = c_; }
    __device__ bool next(int i, Unit& u) const {
        const long L = (long)i * G + c; if (L >= nwg) return false;
        int wgid = (int)L; { const int q = nwg / NXCD, r = nwg % NXCD, xcd = wgid % NXCD, off = wgid / NXCD; wgid = (xcd < r ? xcd * (q + 1) : r * (q + 1) + (xcd - r) * q) + off; }
        const int nig = WGM * nN, gid = wgid / nig, fm = gid * WGM, gsz = (nM - fm) < WGM ? (nM - fm) : WGM;
        u.pm = fm + ((wgid % nig) % gsz); u.pn = (wgid % nig) / gsz; return true;
    }
};
struct EpiBf16Out {
    static constexpr bool PERM = true, I8 = false;
    bf16_t* O; int ldc;
    __device__ __forceinline__ void operator()(const f32x4 (&acc)[2][2][4][2], const Unit& u, int wr, int wc, int fr, int fq) const {
        const int row0 = u.pm * BM + wr * 64 + fr, col0 = u.pn * BM + wc * 32 + 8 * fq;
#pragma unroll
        for (int ai = 0; ai < 2; ++ai)
#pragma unroll
            for (int m = 0; m < 4; ++m) { bf16_t* rowp = O + (size_t)(row0 + ai * HALF + m * 16) * ldc + col0;
#pragma unroll
                for (int bj = 0; bj < 2; ++bj) { const f32x4 v0 = acc[ai][bj][m][0], v1 = acc[ai][bj][m][1];
                    u32x4 w; w.x = pk2(v0[0], v0[1]); w.y = pk2(v0[2], v0[3]); w.z = pk2(v1[0], v1[1]); w.w = pk2(v1[2], v1[3]);
                    *(u32x4*)(rowp + bj * HALF) = w; } }
    }
};
struct EpiResF32 {
    static constexpr bool PERM = false, I8 = false;
    float* C; const float* R; int ldc;
    __device__ __forceinline__ void operator()(const f32x4 (&acc)[2][2][4][2], const Unit& u, int wr, int wc, int fr, int fq) const {
        const int row0 = u.pm * BM + wr * 64 + fr, col0 = u.pn * BM + wc * 32 + 4 * fq;
#pragma unroll
        for (int ai = 0; ai < 2; ++ai)
#pragma unroll
            for (int m = 0; m < 4; ++m) { const size_t off = (size_t)(row0 + ai * HALF + m * 16) * ldc + col0;
#pragma unroll
                for (int bj = 0; bj < 2; ++bj)
#pragma unroll
                    for (int n = 0; n < 2; ++n) *(f32x4*)(C + off + bj * HALF + n * 16) = acc[ai][bj][m][n] + *(const f32x4*)(R + off + bj * HALF + n * 16); }
    }
};

struct EpiBf16OutI8 {
    static constexpr bool PERM = true, I8 = true;
    bf16_t* O; int ldc; const float* sx; const float* sw;
    __device__ __forceinline__ void operator()(const f32x4 (&acc)[2][2][4][2], const Unit& u, int wr, int wc, int fr, int fq) const {
        const int row0 = u.pm * BM + wr * 64 + fr, col0 = u.pn * BM + wc * 32 + 8 * fq;
        f32x4 cs[2][2];
#pragma unroll
        for (int bj = 0; bj < 2; ++bj)
#pragma unroll
            for (int n = 0; n < 2; ++n) cs[bj][n] = *(const f32x4*)(sw + col0 + bj * HALF + 4 * n);
#pragma unroll
        for (int ai = 0; ai < 2; ++ai)
#pragma unroll
            for (int m = 0; m < 4; ++m) { const int row = row0 + ai * HALF + m * 16; const float rsx = sx[row]; bf16_t* rowp = O + (size_t)row * ldc + col0;
#pragma unroll
                for (int bj = 0; bj < 2; ++bj) { const i32x4 a0 = __builtin_bit_cast(i32x4, acc[ai][bj][m][0]), a1 = __builtin_bit_cast(i32x4, acc[ai][bj][m][1]);
                    float v[8];
#pragma unroll
                    for (int j = 0; j < 4; ++j) { v[j] = (float)a0[j] * rsx * cs[bj][0][j]; v[4 + j] = (float)a1[j] * rsx * cs[bj][1][j]; }
                    u32x4 w; w.x = pk2(v[0], v[1]); w.y = pk2(v[2], v[3]); w.z = pk2(v[4], v[5]); w.w = pk2(v[6], v[7]);
                    *(u32x4*)(rowp + bj * HALF) = w; } }
    }
};
template <class Epi>
__device__ __forceinline__ void gemm_phase(LAS unsigned char* lds, const Gemm g, const StaticOrder& S, const Epi& E) {
    const int tid = threadIdx.x, wid = __builtin_amdgcn_readfirstlane(tid >> 6), lane = tid & 63, wr = wid >> 2, wc = wid & 3, fr = lane & 15, fq = lane >> 4;
    const int K = g.K, nt = K / BK;
    unsigned voffA[2], voffB[2];
#pragma unroll
    for (int i = 0; i < 2; ++i) { int R, C; stage_rc(tid * 16 + i * 8192, R, C); const int Rb = Epi::PERM ? ((R & ~31) + perm32(R & 31)) : R;
        voffA[i] = (unsigned)(R * K + C) * 2u; voffB[i] = (unsigned)(Rb * K + C) * 2u; }
    const size_t kstep = (size_t)(BK * 2);
    const size_t hstep = (size_t)HALF * K * 2;
    const size_t tstep = 2 * hstep;
    const unsigned ldsw = (unsigned)wid * 1024u;
    const int aoff = lds_byte(wr * 64 + fr, fq * 8), boff = lds_byte(wc * 32 + fr, fq * 8);
#define PG8_SA(b, h) (((b) * 2 + (h)) * HTB)
#define PG8_SB(b, h) ((4 + (b) * 2 + (h)) * HTB)
#define PG8_STAGE(bufoff, gbase, voff) do { _Pragma("unroll") for (int _i = 0; _i < 2; ++_i) \
        __builtin_amdgcn_global_load_lds((const unsigned*)((const char*)(gbase) + (voff)[_i]), (LAS unsigned*)(lds + (bufoff) + ldsw + _i * 8192), 16, 0, 0); } while (0)
#define PG8_LDA(dst, b, h) do { _Pragma("unroll") for (int m = 0; m < 4; ++m) _Pragma("unroll") for (int k = 0; k < 2; ++k) dst[m][k] = *(const LAS bf16x8*)(lds + PG8_SA(b, h) + aoff + m * 2048 + k * 1024); } while (0)
#define PG8_LDB(dst, b, h) do { _Pragma("unroll") for (int n = 0; n < 2; ++n) _Pragma("unroll") for (int k = 0; k < 2; ++k) dst[n][k] = *(const LAS bf16x8*)(lds + PG8_SB(b, h) + boff + n * 2048 + k * 1024); } while (0)
#define PG8_MMA(ai, bj, At, Bt) do { __builtin_amdgcn_s_setprio(1); _Pragma("unroll") for (int m = 0; m < 4; ++m) _Pragma("unroll") for (int n = 0; n < 2; ++n) _Pragma("unroll") for (int k = 0; k < 2; ++k) \
        { if constexpr (Epi::I8) acc[ai][bj][m][n] = __builtin_bit_cast(f32x4, __builtin_amdgcn_mfma_i32_16x16x64_i8(__builtin_bit_cast(i32x4, Bt[n][k]), __builtin_bit_cast(i32x4, At[m][k]), __builtin_bit_cast(i32x4, acc[ai][bj][m][n]), 0, 0, 0)); \
          else acc[ai][bj][m][n] = __builtin_amdgcn_mfma_f32_16x16x32_bf16(Bt[n][k], At[m][k], acc[ai][bj][m][n], 0, 0, 0); } __builtin_amdgcn_s_setprio(0); } while (0)
#define PG8_WAIT_V(n) asm volatile("s_waitcnt vmcnt(" #n ")" ::: "memory")
#define PG8_WAIT_L(n) asm volatile("s_waitcnt lgkmcnt(" #n ")" ::: "memory")
#define PG8_BAR __builtin_amdgcn_s_barrier()
#define PG8_SCHED __builtin_amdgcn_sched_barrier(0)
    Unit cur, nxt; int ui = 0;
    if (!S.next(0, cur)) return;
    f32x4 acc[2][2][4][2];
#pragma unroll
    for (int a = 0; a < 2; ++a)
#pragma unroll
        for (int b = 0; b < 2; ++b)
#pragma unroll
            for (int m = 0; m < 4; ++m)
#pragma unroll
                for (int n = 0; n < 2; ++n) acc[a][b][m][n] = (f32x4){0.f, 0.f, 0.f, 0.f};
    bf16x8 At[4][2], B0[2][2], B1[2][2];
    const char* cA = (const char*)g.A + (size_t)cur.pm * tstep; const char* cB = (const char*)g.Bt + (size_t)cur.pn * tstep;
    PG8_STAGE(PG8_SB(0, 0), cB, voffB); PG8_STAGE(PG8_SA(0, 0), cA, voffA); PG8_STAGE(PG8_SB(0, 1), cB + hstep, voffB); PG8_STAGE(PG8_SA(0, 1), cA + hstep, voffA);
    if (wr == 1) PG8_BAR;
    PG8_WAIT_V(4); PG8_BAR;
    PG8_STAGE(PG8_SB(1, 0), cB + kstep, voffB); PG8_STAGE(PG8_SA(1, 0), cA + kstep, voffA); PG8_STAGE(PG8_SB(1, 1), cB + hstep + kstep, voffB);
    PG8_WAIT_V(6); PG8_BAR;
    for (;;) {
        const bool has_next = S.next(ui + 1, nxt);
        const char* nA = has_next ? (const char*)g.A + (size_t)nxt.pm * tstep : cA; const char* nB = has_next ? (const char*)g.Bt + (size_t)nxt.pn * tstep : cB;
        for (int t = 0; t < nt; t += 2) {
            const bool last = (t == nt - 2);
            const char* a1 = cA + (size_t)(t + 1) * kstep;
            const char* a2 = last ? nA : cA + (size_t)(t + 2) * kstep; const char* b2 = last ? nB : cB + (size_t)(t + 2) * kstep;
            const char* a3 = a2 + kstep; const char* b3 = b2 + kstep;
            PG8_LDB(B0, 0, 0); PG8_SCHED; PG8_LDA(At, 0, 0); PG8_STAGE(PG8_SA(1, 1), a1 + hstep, voffA);
            PG8_WAIT_L(8); PG8_BAR; PG8_WAIT_L(0); PG8_MMA(0, 0, At, B0); PG8_BAR; PG8_SCHED;
            PG8_LDB(B1, 0, 1); PG8_STAGE(PG8_SB(0, 0), b2, voffB);
            PG8_BAR; PG8_WAIT_L(0); PG8_MMA(0, 1, At, B1); PG8_BAR;
            PG8_LDA(At, 0, 1); PG8_STAGE(PG8_SA(0, 0), a2, voffA);
            PG8_BAR; PG8_WAIT_L(0); PG8_MMA(1, 0, At, B0); PG8_BAR; PG8_SCHED;
            PG8_STAGE(PG8_SB(0, 1), b2 + hstep, voffB);
            PG8_WAIT_V(6); PG8_BAR; PG8_MMA(1, 1, At, B1); PG8_BAR;
            PG8_LDB(B0, 1, 0); PG8_SCHED; PG8_LDA(At, 1, 0); PG8_STAGE(PG8_SA(0, 1), a2 + hstep, voffA);
            PG8_WAIT_L(8); PG8_BAR; PG8_WAIT_L(0); PG8_MMA(0, 0, At, B0); PG8_BAR; PG8_SCHED;
            PG8_LDB(B1, 1, 1); PG8_STAGE(PG8_SB(1, 0), b3, voffB);
            PG8_BAR; PG8_WAIT_L(0); PG8_MMA(0, 1, At, B1); PG8_BAR;
            PG8_LDA(At, 1, 1); PG8_STAGE(PG8_SA(1, 0), a3, voffA);
            PG8_BAR; PG8_WAIT_L(0); PG8_MMA(1, 0, At, B0); PG8_BAR; PG8_SCHED;
            PG8_STAGE(PG8_SB(1, 1), b3 + hstep, voffB);
            PG8_WAIT_V(6); PG8_BAR; PG8_MMA(1, 1, At, B1); PG8_BAR;
        }
        E(acc, cur, wr, wc, fr, fq);
        if (!has_next) break;
#pragma unroll
        for (int a = 0; a < 2; ++a)
#pragma unroll
            for (int b = 0; b < 2; ++b)
#pragma unroll
                for (int m = 0; m < 4; ++m)
#pragma unroll
                    for (int n = 0; n < 2; ++n) acc[a][b][m][n] = (f32x4){0.f, 0.f, 0.f, 0.f};
        cur = nxt; cA = nA; cB = nB; ++ui;
    }
    PG8_WAIT_V(0);
    if (wr == 0) PG8_BAR;
    PG8_BAR;
#undef PG8_SA
#undef PG8_SB
#undef PG8_STAGE
#undef PG8_LDA
#undef PG8_LDB
#undef PG8_MMA
#undef PG8_WAIT_V
#undef PG8_WAIT_L
#undef PG8_BAR
#undef PG8_SCHED
}
}

template <bool WITH_GR, bool WITH_I8 = false>
__device__ __forceinline__ void rmsnorm_rows(const float* src, const float* w, bf16_t* dst, float* gr_out, const float* wgrT, unsigned* q8 = nullptr, float* sx = nullptr) {
    const int lane = otid() & 63, wv = blockIdx.x * 8 + (otid() >> 6), nw = gridDim.x * 8;
    f32x4 wv4[4];
#pragma unroll
    for (int j = 0; j < 4; ++j) wv4[j] = *(const f32x4*)(w + j * 256 + lane * 4);
    for (int t = wv; t < T_; t += nw) {
        const float* row = src + (size_t)t * D_;
        f32x4 v[4]; float ss = 0.f;
#pragma unroll
        for (int j = 0; j < 4; ++j) { v[j] = *(const f32x4*)(row + j * 256 + lane * 4); ss += v[j][0] * v[j][0] + v[j][1] * v[j][1] + v[j][2] * v[j][2] + v[j][3] * v[j][3]; }
        ss = wave_sum(ss);
        const float rs = rsqrtf(ss * (1.0f / D_) + EPS_);
#pragma unroll
        for (int j = 0; j < 4; ++j) { v[j] = v[j] * rs * wv4[j];
            u32x2 o; o.x = pk2(v[j][0], v[j][1]); o.y = pk2(v[j][2], v[j][3]);
            *(u32x2*)(dst + (size_t)t * D_ + j * 256 + lane * 4) = o; }
        if (WITH_I8) {
            float am = 0.f;
#pragma unroll
            for (int j = 0; j < 4; ++j) am = fmaxf(am, fmaxf(fmaxf(fabsf(v[j][0]), fabsf(v[j][1])), fmaxf(fabsf(v[j][2]), fabsf(v[j][3]))));
            for (int o = 32; o > 0; o >>= 1) am = fmaxf(am, __shfl_xor(am, o));
            const float qs = am > 0.f ? 127.0f / am : 0.f;
#pragma unroll
            for (int j = 0; j < 4; ++j) { unsigned pkd = 0u;
#pragma unroll
                for (int i = 0; i < 4; ++i) { const int qi = (int)rintf(v[j][i] * qs); pkd |= ((unsigned)qi & 0xffu) << (8 * i); }
                q8[(size_t)t * 256 + j * 64 + lane] = pkd; }
            if (lane == 0) sx[t] = am * (1.0f / 127.0f);
        }
        if (WITH_GR) {
            float pr[16];
#pragma unroll
            for (int r = 0; r < 16; ++r) { float pp = 0.f;
#pragma unroll
                for (int j = 0; j < 4; ++j) { const f32x4 ww = *(const f32x4*)(wgrT + r * 1024 + j * 256 + lane * 4); pp += v[j][0] * ww[0] + v[j][1] * ww[1] + v[j][2] * ww[2] + v[j][3] * ww[3]; }
                pr[r] = pp; }
            const bool b5 = lane & 32, b4 = lane & 16, b3 = lane & 8, b2 = lane & 4;
            float a8[8], a4[4], a2[2], a1;
#pragma unroll
            for (int i = 0; i < 8; ++i) { const float a = b5 ? pr[i + 8] : pr[i], bb = b5 ? pr[i] : pr[i + 8]; a8[i] = a + __shfl_xor(bb, 32); }
#pragma unroll
            for (int i = 0; i < 4; ++i) { const float a = b4 ? a8[i + 4] : a8[i], bb = b4 ? a8[i] : a8[i + 4]; a4[i] = a + __shfl_xor(bb, 16); }
#pragma unroll
            for (int i = 0; i < 2; ++i) { const float a = b3 ? a4[i + 2] : a4[i], bb = b3 ? a4[i] : a4[i + 2]; a2[i] = a + __shfl_xor(bb, 8); }
            { const float a = b2 ? a2[1] : a2[0], bb = b2 ? a2[0] : a2[1]; a1 = a + __shfl_xor(bb, 4); }
            a1 += __shfl_xor(a1, 2); a1 += __shfl_xor(a1, 1);
            const int ridx = ((lane >> 5) & 1) * 8 + ((lane >> 4) & 1) * 4 + ((lane >> 3) & 1) * 2 + ((lane >> 2) & 1);
            if ((lane & 3) == 0) gr_out[(size_t)t * 16 + ridx] = a1;
        }
    }
}

__device__ void phase_prep(const Params& p, unsigned char* shm) {
    const int tid = otid();
    float* wgrT = (float*)shm;
    float* tile = (float*)(shm + 65536);
    for (int idx = tid; idx < 16384; idx += NTHR) { const int k = idx >> 4, r = idx & 15; wgrT[r * 1024 + k] = p.w_in[(size_t)k * WIN_LD + 1536 + r]; }
    __syncthreads();
    rmsnorm_rows<true>(p.x, p.norm1_w, (bf16_t*)(p.ws + WS_XN), (float*)(p.ws + WS_GR), wgrT);
    for (int tl = blockIdx.x; tl < 1536; tl += gridDim.x) {
        const float* src; bf16_t* dst; int ld, kt, ntile, scol;
        if (tl < 768) { src = p.w_in; dst = (bf16_t*)(p.ws + WS_WIN); ld = WIN_LD; kt = tl & 15; ntile = tl >> 4; scol = ntile * 64 + (ntile * 64 >= 1536 ? 16 : 0); }
        else if (tl < 1024) { const int q = tl - 768; src = p.w_out; dst = (bf16_t*)(p.ws + WS_WOUT); ld = 1024; kt = q & 15; ntile = q >> 4; scol = ntile * 64; }
        else { const int q = tl - 1024; src = p.w_query; dst = (bf16_t*)(p.ws + WS_WQ); ld = 2048; kt = q & 15; ntile = q >> 4; scol = ntile * 64; }
        const int k0 = kt * 64, n0 = ntile * 64;
#pragma unroll
        for (int i = 0; i < 8; ++i) { const int r = (tid >> 6) + 8 * i, c = tid & 63; tile[r * 65 + c] = src[(size_t)(k0 + r) * ld + scol + c]; }
        __syncthreads();
#pragma unroll
        for (int i = 0; i < 8; ++i) { const int nn = (tid >> 6) + 8 * i, kk = tid & 63; dst[(size_t)(n0 + nn) * 1024 + k0 + kk] = f2bf(tile[kk * 65 + nn]); }
        __syncthreads();
    }
    const size_t gtid = (size_t)blockIdx.x * NTHR + tid, gn = (size_t)gridDim.x * NTHR;
    for (int which = 0; which < 2; ++which) {
        const float* src = which ? p.peer_v : p.peer_u; unsigned char* dst = p.ws + (which ? WS_V : WS_U); const float sc = which ? 64.0f : 256.0f;
        for (size_t i = gtid; i < (size_t)16384 * 1024 / 16; i += gn) {
            u32x4 o;
#pragma unroll
            for (int q4 = 0; q4 < 4; ++q4) { const f32x4 a = *(const f32x4*)(src + i * 16 + q4 * 4);
                int w = __builtin_amdgcn_cvt_pk_fp8_f32(a[0] * sc, a[1] * sc, 0, false); w = __builtin_amdgcn_cvt_pk_fp8_f32(a[2] * sc, a[3] * sc, w, true); o[q4] = (unsigned)w; }
            *(u32x4*)(dst + i * 16) = o; }
    }
    { bf16_t* dst = (bf16_t*)(p.ws + WS_SK);
      for (size_t i = gtid; i < (size_t)262144 / 8; i += gn) {
          const f32x4 a = *(const f32x4*)(p.subkeys + i * 8), b = *(const f32x4*)(p.subkeys + i * 8 + 4);
          u32x4 o; o.x = pk2(a[0], a[1]); o.y = pk2(a[2], a[3]); o.z = pk2(b[0], b[1]); o.w = pk2(b[2], b[3]);
          *(u32x4*)(dst + i * 8) = o; } }
    { float* rt = (float*)(p.ws + WS_ROPE);
      for (size_t i = gtid; i < (size_t)4096 * 32; i += gn) {
          const int pos = (int)(i >> 5), k = (int)(i & 31);
          const float inv = (float)exp(-(double)k * (9.210340371976184 / 32.0));
          const float ang = (float)pos * inv;
          double rev = (double)ang * 0.15915494309189535; rev -= floor(rev);
          rt[i] = __builtin_amdgcn_cosf((float)rev); rt[131072 + i] = __builtin_amdgcn_sinf((float)rev); } }
}

__device__ void moba_prep_item(const Params& p, unsigned char* shm, int item) {
    const int tid = otid();
    const int h = item & 7, blk = (item >> 3) & 15, b = item >> 7, bh = b * 8 + h;
    bf16_t* proj = (bf16_t*)(p.ws + WS_PROJ);
    const float* rope = (const float*)(p.ws + WS_ROPE);
    float* kt = (float*)shm;
    unsigned* vt = (unsigned*)(shm + 66560);
    float* part = (float*)(shm + 66560 + 33792);
    const int tl = tid & 255, which = tid >> 8;
    const size_t trow = (size_t)(b * S_ + blk * 256 + tl);
    {
        bf16_t* ptr = proj + trow * NPROJ + (which ? C_MK : C_MQ) + h * 64;
        const float* nw = which ? p.mkw : p.mqw;
        float v[64]; float ss = 0.f;
#pragma unroll
        for (int i = 0; i < 8; ++i) { const u32x4 w = *(const u32x4*)(ptr + i * 8); unpack8(w, v + i * 8); }
#pragma unroll
        for (int i = 0; i < 64; ++i) ss += v[i] * v[i];
        const float rs = rsqrtf(ss * (1.0f / 64) + EPS_);
        const float qsc = which ? 1.0f : 0.18033688f;
        const int pos = blk * 256 + tl;
        const float* cp = rope + (size_t)pos * 32; const float* sp = cp + 131072;
#pragma unroll
        for (int i = 0; i < 32; i += 4) {
            const f32x4 c4 = *(const f32x4*)(cp + i), s4 = *(const f32x4*)(sp + i), w1 = *(const f32x4*)(nw + i), w2 = *(const f32x4*)(nw + 32 + i);
#pragma unroll
            for (int j = 0; j < 4; ++j) { const float x1 = v[i + j] * rs * w1[j] * qsc, x2 = v[32 + i + j] * rs * w2[j] * qsc;
                v[i + j] = x1 * c4[j] - x2 * s4[j]; v[32 + i + j] = x2 * c4[j] + x1 * s4[j]; }
        }
#pragma unroll
        for (int i = 0; i < 8; ++i) { u32x4 w; w.x = pk2(v[i * 8], v[i * 8 + 1]); w.y = pk2(v[i * 8 + 2], v[i * 8 + 3]); w.z = pk2(v[i * 8 + 4], v[i * 8 + 5]); w.w = pk2(v[i * 8 + 6], v[i * 8 + 7]); *(u32x4*)(ptr + i * 8) = w; }
        if (which) {
#pragma unroll
            for (int i = 0; i < 64; ++i) kt[tl * 65 + i] = v[i];
        }
    }
    {
        const bf16_t* ptr = proj + trow * NPROJ + C_MV + h * 64 + which * 32;
#pragma unroll
        for (int i = 0; i < 4; ++i) { const u32x4 w = *(const u32x4*)(ptr + i * 8); unsigned* d = vt + tl * 33 + which * 16 + i * 4; d[0] = w.x; d[1] = w.y; d[2] = w.z; d[3] = w.w; }
    }
    __syncthreads();
    {
        const int d = tid & 63, pr = tid >> 6; float s = 0.f;
#pragma unroll 8
        for (int r = 0; r < 32; ++r) s += kt[(pr * 32 + r) * 65 + d];
        part[pr * 64 + d] = s;
    }
    {
        const int d = tid >> 3, seg = tid & 7;
        bf16_t* dst = (bf16_t*)((unsigned char*)p.out + OUT_MVT) + ((size_t)bh * 64 + d) * S_ + blk * 256 + seg * 32;
        const bf16_t* vs = (const bf16_t*)vt;
        unsigned o[16];
#pragma unroll
        for (int i = 0; i < 16; ++i) { const unsigned lo = vs[(seg * 32 + 2 * i) * 66 + d], hi = vs[(seg * 32 + 2 * i + 1) * 66 + d]; o[i] = lo | (hi << 16); }
#pragma unroll
        for (int i = 0; i < 4; ++i) { u32x4 w; w.x = o[i * 4]; w.y = o[i * 4 + 1]; w.z = o[i * 4 + 2]; w.w = o[i * 4 + 3]; *(u32x4*)(dst + i * 8) = w; }
    }
    __syncthreads();
    if (tid < 64) { float s = 0.f;
#pragma unroll
        for (int i = 0; i < 8; ++i) s += part[i * 64 + tid];
        ((float*)((unsigned char*)p.out + OUT_KBAR))[((size_t)bh * 16 + blk) * 64 + tid] = s * (1.0f / 256); }
    __syncthreads();
}

__device__ void gla_local_item(const Params& p, unsigned char* shm, int item) {
    const int tid = otid(), lane = tid & 63, wv = tid >> 6, g = lane >> 4, lr = lane & 15;
    const int n = item & 63, h = (item >> 6) & 3, b = item >> 8, bh = b * 4 + h;
    const size_t t0 = (size_t)b * S_ + n * 64;
    bf16_t* proj = (bf16_t*)(p.ws + WS_PROJ);
    float* gr_s = (float*)shm;
    float* wa_s = (float*)(shm + 4096);
    float* ba_s = (float*)(shm + 8192);
    float* g_s = (float*)(shm + 8704);
    float* tot_s = (float*)(shm + 8704 + 16384);
    bf16_t* kstT = (bf16_t*)(shm + 27136);
    bf16_t* vT = (bf16_t*)(shm + 27136 + 9216);
    const float* gr = (const float*)(p.ws + WS_GR);
    for (int i = tid; i < 1024; i += NTHR) { gr_s[i] = gr[t0 * 16 + i]; wa_s[i] = p.w_alpha[(size_t)(i >> 6) * 256 + h * 64 + (i & 63)]; }
    if (tid < 64) ba_s[tid] = p.b_alpha[h * 64 + tid];
    __syncthreads();
    { const int c = tid >> 3, dg = tid & 7;
#pragma unroll
      for (int dd = 0; dd < 8; ++dd) { const int d = dg * 8 + dd; float z = ba_s[d];
#pragma unroll
          for (int r = 0; r < 16; ++r) z += gr_s[c * 16 + r] * wa_s[r * 64 + d];
          const float ls = fminf(z, 0.f) - __logf(1.0f + __expf(-fabsf(z)));
          g_s[c * 64 + d] = ls * (1.0f / 16.0f); } }
    __syncthreads();
    { const int d = tid & 63, seg = tid >> 6; float run = 0.f;
#pragma unroll
      for (int i = 0; i < 8; ++i) { run += g_s[(seg * 8 + i) * 64 + d]; g_s[(seg * 8 + i) * 64 + d] = run; }
      tot_s[seg * 64 + d] = run; }
    __syncthreads();
    { const int d = tid & 63, seg = tid >> 6; float off = 0.f;
      for (int s = 0; s < seg; ++s) off += tot_s[s * 64 + d];
#pragma unroll
      for (int i = 0; i < 8; ++i) g_s[(seg * 8 + i) * 64 + d] += off; }
    __syncthreads();
    { const int c = tid >> 3, dg = tid & 7;
      bf16_t* qp = proj + (t0 + c) * NPROJ + C_GQ + h * 64 + dg * 8; bf16_t* kp = proj + (t0 + c) * NPROJ + C_GK + h * 64 + dg * 8;
      float q[8], k[8]; unpack8(*(const u32x4*)qp, q); unpack8(*(const u32x4*)kp, k);
      float qd[8], ki[8];
#pragma unroll
      for (int dd = 0; dd < 8; ++dd) { const int d = dg * 8 + dd; const float bb = g_s[c * 64 + d], bl = g_s[63 * 64 + d];
          qd[dd] = q[dd] * __expf(bb) * 0.125f; ki[dd] = k[dd] * __expf(-bb); kstT[d * 72 + c] = f2bf(k[dd] * __expf(bl - bb)); }
      u32x4 w; w.x = pk2(qd[0], qd[1]); w.y = pk2(qd[2], qd[3]); w.z = pk2(qd[4], qd[5]); w.w = pk2(qd[6], qd[7]); *(u32x4*)qp = w;
      w.x = pk2(ki[0], ki[1]); w.y = pk2(ki[2], ki[3]); w.z = pk2(ki[4], ki[5]); w.w = pk2(ki[6], ki[7]); *(u32x4*)kp = w;
      const bf16_t* vp = proj + (t0 + c) * NPROJ + C_GV + h * 128 + dg * 16;
#pragma unroll
      for (int i = 0; i < 2; ++i) { const u32x4 vv = *(const u32x4*)(vp + i * 8); const int e0 = dg * 16 + i * 8;
          vT[(e0 + 0) * 72 + c] = (bf16_t)(vv.x & 0xffff); vT[(e0 + 1) * 72 + c] = (bf16_t)(vv.x >> 16);
          vT[(e0 + 2) * 72 + c] = (bf16_t)(vv.y & 0xffff); vT[(e0 + 3) * 72 + c] = (bf16_t)(vv.y >> 16);
          vT[(e0 + 4) * 72 + c] = (bf16_t)(vv.z & 0xffff); vT[(e0 + 5) * 72 + c] = (bf16_t)(vv.z >> 16);
          vT[(e0 + 6) * 72 + c] = (bf16_t)(vv.w & 0xffff); vT[(e0 + 7) * 72 + c] = (bf16_t)(vv.w >> 16); }
      if (tid < 64) ((float*)(p.ws + WS_DECAY))[((size_t)bh * 64 + n) * 64 + tid] = expf(g_s[63 * 64 + tid]);
    }
    __syncthreads();
    {
      const int e = tid >> 2, cs = tid & 3;
      bf16_t* dst = (bf16_t*)((unsigned char*)p.out + OUT_GVT) + ((size_t)bh * 128 + e) * S_ + n * 64 + cs * 16;
      *(u32x4*)dst = *(const u32x4*)(vT + e * 72 + cs * 16); *(u32x4*)(dst + 8) = *(const u32x4*)(vT + e * 72 + cs * 16 + 8); }
    {
      f32x4 acc[4];
#pragma unroll
      for (int dt = 0; dt < 4; ++dt) acc[dt] = (f32x4){0.f, 0.f, 0.f, 0.f};
#pragma unroll
      for (int ks = 0; ks < 2; ++ks) { const bf16x8 a = *(const bf16x8*)(vT + (wv * 16 + lr) * 72 + ks * 32 + g * 8);
#pragma unroll
          for (int dt = 0; dt < 4; ++dt) { const bf16x8 bb = *(const bf16x8*)(kstT + (dt * 16 + lr) * 72 + ks * 32 + g * 8); acc[dt] = MFMA32(a, bb, acc[dt]); } }
      float* st = (float*)(p.ws + WS_XN) + ((size_t)bh * 64 + n) * 8192;
#pragma unroll
      for (int dt = 0; dt < 4; ++dt)
#pragma unroll
          for (int j = 0; j < 4; ++j) st[(wv * 16 + g * 4 + j) * 64 + dt * 16 + lr] = acc[dt][j]; }
    __syncthreads();
}

__device__ void quant_wq(const Params& p) {
    const int lane = otid() & 63, wg = blockIdx.x * 8 + (otid() >> 6), nw = gridDim.x * 8;
    const bf16_t* wq = (const bf16_t*)(p.ws + WS_WQ); unsigned char* w8 = p.ws + WS_WQ8; float* sw = (float*)(p.ws + WS_SW);
    for (int n = wg; n < 2048; n += nw) {
        float f[16]; const u32x4* rp = (const u32x4*)(wq + (size_t)n * 1024 + lane * 16); unpack8(rp[0], f); unpack8(rp[1], f + 8);
        float am = 0.f;
#pragma unroll
        for (int i = 0; i < 16; ++i) am = fmaxf(am, fabsf(f[i]));
        for (int o = 32; o > 0; o >>= 1) am = fmaxf(am, __shfl_xor(am, o));
        const float qs = am > 0.f ? 127.0f / am : 0.f;
        u32x4 o4;
#pragma unroll
        for (int q = 0; q < 4; ++q) { unsigned pkd = 0u;
#pragma unroll
            for (int i = 0; i < 4; ++i) { const int qi = (int)rintf(f[q * 4 + i] * qs); pkd |= ((unsigned)qi & 0xffu) << (8 * i); }
            o4[q] = pkd; }
        *(u32x4*)(w8 + (size_t)n * 1024 + lane * 16) = o4;
        if (lane == 0) sw[n] = am * (1.0f / 127.0f);
    }
}
__device__ void phase_mixprep(const Params& p, unsigned char* shm) {
    quant_wq(p);
    for (int it = blockIdx.x; it < 1536; it += gridDim.x) { if (it < 512) moba_prep_item(p, shm, it); else gla_local_item(p, shm, it - 512); }
}

__device__ void gla_scan(const Params& p) {
    const int gid = blockIdx.x * NTHR + otid(), gn = gridDim.x * NTHR;
    float* st = (float*)(p.ws + WS_XN); const float* dec = (const float*)(p.ws + WS_DECAY);
    for (int e = gid; e < 16 * 8192; e += gn) {
        const int bh = e >> 13, el = e & 8191, d = el & 63; float s = 0.f;
        for (int n0 = 0; n0 < 64; n0 += 8) { float u[8], dc[8];
#pragma unroll
            for (int k = 0; k < 8; ++k) { u[k] = st[((size_t)bh * 64 + n0 + k) * 8192 + el]; dc[k] = dec[((size_t)bh * 64 + n0 + k) * 64 + d]; }
#pragma unroll
            for (int k = 0; k < 8; ++k) { st[((size_t)bh * 64 + n0 + k) * 8192 + el] = s; s = dc[k] * s + u[k]; } }
    }
}

__device__ void moba_attn_item(const Params& p, unsigned char* shm, int bh, int blk) {
    const int tid = otid(), lane = tid & 63, wv = tid >> 6, g = lane >> 4, lr = lane & 15;
    const int b = bh >> 3, h = bh & 7, q0 = blk * 256;
    const bf16_t* proj = (const bf16_t*)(p.ws + WS_PROJ);
    const bf16_t* mvT = (const bf16_t*)((unsigned char*)p.out + OUT_MVT) + (size_t)bh * 64 * S_;
    const float* kbar = (const float*)((unsigned char*)p.out + OUT_KBAR) + (size_t)bh * 16 * 64;
    bf16_t* Ks = (bf16_t*)shm;
    bf16_t* VTs = (bf16_t*)(shm + 36864);
    unsigned* sel_s = (unsigned*)(shm + 36864 + 34816);
    if (tid == 0) sel_s[256] = 0u;
    if (tid < 64) {
        float aq = fabsf(p.mqw[tid]), ak = fabsf(p.mkw[tid]);
        for (int o = 32; o > 0; o >>= 1) { aq = fmaxf(aq, __shfl_xor(aq, o)); ak = fmaxf(ak, __shfl_xor(ak, o)); }
        if (tid == 0) ((float*)sel_s)[257] = 8.2f * aq * ak * 1.44269504f;
    }
    __syncthreads();
    if (tid < 256) {
        unsigned mask;
        if (blk <= 3) mask = (1u << blk) - 1u;
        else {
            float q[64]; const bf16_t* qp = proj + ((size_t)b * S_ + q0 + tid) * NPROJ + C_MQ + h * 64;
#pragma unroll
            for (int i = 0; i < 8; ++i) unpack8(*(const u32x4*)(qp + i * 8), q + i * 8);
            float v0 = -INFINITY, v1 = -INFINITY, v2 = -INFINITY; int i0 = 0, i1 = 0, i2 = 0;
            for (int j = 0; j < blk; ++j) { float s = 0.f;
#pragma unroll
                for (int i = 0; i < 64; i += 4) { const f32x4 kk = *(const f32x4*)(kbar + j * 64 + i); s += q[i] * kk[0] + q[i + 1] * kk[1] + q[i + 2] * kk[2] + q[i + 3] * kk[3]; }
                if (s > v0) { v2 = v1; i2 = i1; v1 = v0; i1 = i0; v0 = s; i0 = j; } else if (s > v1) { v2 = v1; i2 = i1; v1 = s; i1 = j; } else if (s > v2) { v2 = s; i2 = j; } }
            mask = (1u << i0) | (1u << i1) | (1u << i2);
        }
        sel_s[tid] = mask; atomicOr(&sel_s[256], mask);
    }
    __syncthreads();
    const unsigned umask = sel_s[256]; const float mbound = ((const float*)sel_s)[257];
    unsigned mysel[2]; int qabs[2]; bf16x8 qb[2][2]; f32x4 acc[2][4], lacc[2];
    const bf16x8 ones = {(short)0x3F80, (short)0x3F80, (short)0x3F80, (short)0x3F80, (short)0x3F80, (short)0x3F80, (short)0x3F80, (short)0x3F80};
#pragma unroll
    for (int u = 0; u < 2; ++u) {
        mysel[u] = sel_s[wv * 32 + u * 16 + lr]; qabs[u] = q0 + wv * 32 + u * 16 + lr;
        const bf16_t* qp = proj + ((size_t)b * S_ + qabs[u]) * NPROJ + C_MQ + h * 64 + g * 8; qb[u][0] = *(const bf16x8*)qp; qb[u][1] = *(const bf16x8*)(qp + 32);
#pragma unroll
        for (int dt = 0; dt < 4; ++dt) acc[u][dt] = (f32x4){0.f, 0.f, 0.f, 0.f};
        lacc[u] = (f32x4){0.f, 0.f, 0.f, 0.f}; }
    const int bp32 = (lane ^ 32) * 4;
    u32x4 kreg[4], vreg[4];
    int j = 0; while (j < blk && !((umask >> j) & 1u)) ++j;
#define MOBA_LOAD(jj) do { _Pragma("unroll") for (int i = 0; i < 4; ++i) { const int c = tid + NTHR * i; \
            kreg[i] = *(const u32x4*)(proj + ((size_t)b * S_ + (jj) * 256 + (c >> 3)) * NPROJ + C_MK + h * 64 + (c & 7) * 8); \
            vreg[i] = *(const u32x4*)(mvT + (size_t)(c >> 5) * S_ + (jj) * 256 + (c & 31) * 8); } } while (0)
#define MOBA_STORE() do { _Pragma("unroll") for (int i = 0; i < 4; ++i) { const int c = tid + NTHR * i; \
            *(u32x4*)(Ks + (c >> 3) * 72 + (c & 7) * 8) = kreg[i]; *(u32x4*)(VTs + (c >> 5) * 272 + (c & 31) * 8) = vreg[i]; } } while (0)
    MOBA_LOAD(j); MOBA_STORE();
    __syncthreads();
    while (j <= blk) {
        int jn = j + 1; while (jn < blk && !((umask >> jn) & 1u)) ++jn;
        if (jn <= blk) MOBA_LOAD(jn);
        const bool own = (j == blk);
        const bool on0 = own || ((mysel[0] >> j) & 1u), on1 = own || ((mysel[1] >> j) & 1u);
        if (__any(on0 || on1)) {
            const float bias[2] = {on0 ? -mbound : -INFINITY, on1 ? -mbound : -INFINITY};
            const int kend = own ? wv + 1 : 8;
            for (int kk = 0; kk < kend; ++kk) {
                bf16x8 kf[2][2];
#pragma unroll
                for (int hf = 0; hf < 2; ++hf) { const bf16_t* kp = Ks + (kk * 32 + hf * 16 + lr) * 72 + g * 8; kf[hf][0] = *(const bf16x8*)kp; kf[hf][1] = *(const bf16x8*)(kp + 32); }
                bf16x8 vf[4];
#pragma unroll
                for (int dt = 0; dt < 4; ++dt) { const bf16_t* vp = VTs + (dt * 16 + lr) * 272 + kk * 32 + g * 4; vf[dt] = as_bf16x8_2(*(const u32x2*)vp, *(const u32x2*)(vp + 16)); }
                const bool diag = own && (kk == wv);
                bf16x8 pb[2];
#pragma unroll
                for (int u = 0; u < 2; ++u) {
                    f32x4 st[2];
#pragma unroll
                    for (int hf = 0; hf < 2; ++hf) { st[hf] = MFMA32(kf[hf][0], qb[u][0], ((f32x4){bias[u], bias[u], bias[u], bias[u]})); st[hf] = MFMA32(kf[hf][1], qb[u][1], st[hf]); }
                    float sv[8];
#pragma unroll
                    for (int hf = 0; hf < 2; ++hf)
#pragma unroll
                        for (int jj = 0; jj < 4; ++jj) sv[hf * 4 + jj] = st[hf][jj];
                    if (diag) {
#pragma unroll
                        for (int hf = 0; hf < 2; ++hf)
#pragma unroll
                            for (int jj = 0; jj < 4; ++jj) if (j * 256 + kk * 32 + hf * 16 + g * 4 + jj > qabs[u]) sv[hf * 4 + jj] = -INFINITY;
                    }
                    float pv[8];
#pragma unroll
                    for (int i = 0; i < 8; ++i) pv[i] = __builtin_amdgcn_exp2f(sv[i]);
                    u32x4 pw; pw.x = pk2(pv[0], pv[1]); pw.y = pk2(pv[2], pv[3]); pw.z = pk2(pv[4], pv[5]); pw.w = pk2(pv[6], pv[7]);
                    pb[u] = as_bf16x8(pw);
                }
#pragma unroll
                for (int u = 0; u < 2; ++u) {
#pragma unroll
                    for (int dt = 0; dt < 4; ++dt) acc[u][dt] = MFMA32(vf[dt], pb[u], acc[u][dt]);
                    lacc[u] = MFMA32(ones, pb[u], lacc[u]); }
            }
        }
        __syncthreads();
        if (jn <= blk) MOBA_STORE();
        __syncthreads();
        j = jn;
    }
#undef MOBA_LOAD
#undef MOBA_STORE
#pragma unroll
    for (int u = 0; u < 2; ++u) {
        const float il = 1.0f / lacc[u][0];
        bf16_t* mixed = (bf16_t*)(p.ws + WS_MIXED) + ((size_t)b * S_ + qabs[u]) * 1024 + 512 + h * 64;
#pragma unroll
        for (int dt = 0; dt < 4; ++dt) { const f32x4 sc = *(const f32x4*)(p.mix_scale + 512 + h * 64 + dt * 16 + g * 4);
            u32x2 o; o.x = pk2(acc[u][dt][0] * il * sc[0], acc[u][dt][1] * il * sc[1]); o.y = pk2(acc[u][dt][2] * il * sc[2], acc[u][dt][3] * il * sc[3]);
            *(u32x2*)(mixed + dt * 16 + g * 4) = o; }
    }
}

__device__ void phase_moba(const Params& p, unsigned char* shm) {
    for (int it = blockIdx.x; it < 512; it += gridDim.x) {
        const int j = it & 255, r = it >> 8, a = j >> 5, bh = j & 31;
        moba_attn_item(p, shm, bh, r ? 15 - a : a);
    }
}
__device__ void phase_scan_moba(const Params& p, unsigned char* shm) { gla_scan(p); phase_moba(p, shm); }

__device__ void gla_out_task(const Params& p, int item, int it) {
    const int lane = otid() & 63, g = lane >> 4, lr = lane & 15;
    const int n = item & 63, h = (item >> 6) & 3, b = item >> 8, bh = b * 4 + h;
    const size_t t0 = (size_t)b * S_ + n * 64; const int i0 = it * 16;
    const bf16_t* proj = (const bf16_t*)(p.ws + WS_PROJ);
    const bf16_t* gvT = (const bf16_t*)((unsigned char*)p.out + OUT_GVT) + (size_t)bh * 128 * S_ + n * 64;
    const float* st = (const float*)(p.ws + WS_XN) + ((size_t)bh * 64 + n) * 8192;
    bf16x8 qd[2];
    { const bf16_t* qp = proj + (t0 + i0 + lr) * NPROJ + C_GQ + h * 64 + g * 8; qd[0] = *(const bf16x8*)qp; qd[1] = *(const bf16x8*)(qp + 32); }
    f32x4 acc[8];
#pragma unroll
    for (int et = 0; et < 8; ++et) acc[et] = (f32x4){0.f, 0.f, 0.f, 0.f};
#pragma unroll
    for (int et = 0; et < 8; ++et)
#pragma unroll
        for (int ks = 0; ks < 2; ++ks) { const float* sp = st + (et * 16 + lr) * 64 + ks * 32 + g * 8; const f32x4 a = *(const f32x4*)sp, c = *(const f32x4*)(sp + 4);
            u32x4 w; w.x = pk2(a[0], a[1]); w.y = pk2(a[2], a[3]); w.z = pk2(c[0], c[1]); w.w = pk2(c[2], c[3]);
            acc[et] = MFMA32(as_bf16x8(w), qd[ks], acc[et]); }
    for (int jt = 0; jt <= it; ++jt) {
        const int j0 = jt * 16;
        const bf16_t* kp = proj + (t0 + j0 + lr) * NPROJ + C_GK + h * 64 + g * 8;
        f32x4 at = MFMA32(*(const bf16x8*)kp, qd[0], ((f32x4){0.f, 0.f, 0.f, 0.f})); at = MFMA32(*(const bf16x8*)(kp + 32), qd[1], at);
#pragma unroll
        for (int jj = 0; jj < 4; ++jj) if (j0 + g * 4 + jj > i0 + lr) at[jj] = 0.f;
        u32x2 aw; aw.x = pk2(at[0], at[1]); aw.y = pk2(at[2], at[3]);
        const bf16x4 ab = as_bf16x4(aw);
#pragma unroll
        for (int et = 0; et < 8; ++et) { const u32x2 vv = *(const u32x2*)(gvT + (size_t)(et * 16 + lr) * S_ + j0 + g * 4); acc[et] = MFMA16(as_bf16x4(vv), ab, acc[et]); }
    }
    float ss = 0.f;
#pragma unroll
    for (int et = 0; et < 8; ++et) ss += acc[et][0] * acc[et][0] + acc[et][1] * acc[et][1] + acc[et][2] * acc[et][2] + acc[et][3] * acc[et][3];
    ss += __shfl_xor(ss, 16); ss += __shfl_xor(ss, 32);
    const float rs = rsqrtf(ss * (1.0f / 128) + EPS_);
    const size_t t = t0 + i0 + lr;
    bf16_t* mixed = (bf16_t*)(p.ws + WS_MIXED) + t * 1024 + h * 128;
#pragma unroll
    for (int et = 0; et < 8; ++et) { const int e0 = et * 16 + g * 4;
        const f32x4 w = *(const f32x4*)(p.gla_onw + e0), sc = *(const f32x4*)(p.mix_scale + h * 128 + e0);
        const u32x2 gw = *(const u32x2*)(proj + t * NPROJ + C_GG + h * 128 + e0);
        const float gt[4] = {lo_f(gw.x), hi_f(gw.x), lo_f(gw.y), hi_f(gw.y)}; float y[4];
#pragma unroll
        for (int j = 0; j < 4; ++j) { const float sl = gt[j] / (1.0f + __expf(-gt[j])); y[j] = acc[et][j] * rs * w[j] * sl * sc[j]; }
        u32x2 o; o.x = pk2(y[0], y[1]); o.y = pk2(y[2], y[3]); *(u32x2*)(mixed + e0) = o; }
}
__device__ void phase_gla_out(const Params& p) {
    const int wg = blockIdx.x * 8 + (otid() >> 6), nw = gridDim.x * 8; int rnd = 0;
    for (int tk = wg; tk < 4096; tk += nw, ++rnd) { const int it = (rnd & 1) ? 3 - (tk & 3) : (tk & 3); gla_out_task(p, tk >> 2, it); }
}

__constant__ unsigned char c_stair[52] = {
    0x00, 0x01, 0x02, 0x03, 0x04, 0x05, 0x06, 0x07, 0x08, 0x09, 0x0a, 0x0b, 0x0c, 0x0d, 0x0e, 0x0f,
    0x10, 0x11, 0x12, 0x13, 0x14, 0x15, 0x16, 0x17, 0x20, 0x21, 0x22, 0x23, 0x24, 0x30, 0x31, 0x32, 0x33,
    0x40, 0x41, 0x42, 0x50, 0x51, 0x60, 0x61, 0x70, 0x71, 0x80, 0x90, 0xa0, 0xb0, 0xc0, 0xd0, 0xe0, 0xf0, 0x00, 0x00};

__device__ void peer_topk_task(const Params& p, unsigned char* shm, int grp, int h) {
    const int lane = otid() & 63, wv = otid() >> 6, g = lane >> 4, lr = lane & 15;
    const bf16_t* sk_s = (const bf16_t*)shm;
    float* sv_s = (float*)(shm + 69632 + wv * 4096);
    int* si_s = (int*)(shm + 69632 + wv * 4096 + 2048);
    const unsigned char* stair_s = (const unsigned char*)(shm + 69632 + 8 * 4096);
    const bf16_t* q = (const bf16_t*)(p.ws + WS_PROJ) + ((size_t)grp * 16 + lr) * 2048 + h * 256;
    const int bp32 = (lane ^ 32) * 4;
#pragma unroll 1
    for (int pp = 0; pp < 2; ++pp) {
        bf16x8 qf[4];
#pragma unroll
        for (int ks = 0; ks < 4; ++ks) qf[ks] = *(const bf16x8*)(q + pp * 128 + ks * 32 + g * 8);
        unsigned pk[32];
#pragma unroll
        for (int kt = 0; kt < 8; ++kt) { f32x4 a = (f32x4){0.f, 0.f, 0.f, 0.f};
#pragma unroll
            for (int ks = 0; ks < 4; ++ks) a = MFMA32(*(const bf16x8*)(sk_s + (pp * 128 + kt * 16 + lr) * 136 + ks * 32 + g * 8), qf[ks], a);
#pragma unroll
            for (int jj = 0; jj < 4; ++jj) pk[kt * 4 + jj] = (ordf(a[jj]) & ~127u) | (unsigned)(127 - (kt * 16 + g * 4 + jj)); }
        unsigned thr = 0u;
#pragma unroll 1
        for (int r = 0; r < 16; ++r) {
            unsigned dm = pk[0] - thr;
#pragma unroll
            for (int i = 1; i < 32; ++i) dm = max(dm, pk[i] - thr);
            dm = max(dm, (unsigned)__builtin_amdgcn_ds_swizzle((int)dm, 0x401F)); dm = max(dm, (unsigned)__builtin_amdgcn_ds_bpermute(bp32, (int)dm));
            const unsigned mm = dm + thr; thr = mm;
            if (g == 0) { sv_s[(pp * 16 + r) * 16 + lr] = unordf(mm & ~127u); si_s[(pp * 16 + r) * 16 + lr] = 127 - (int)(mm & 127u); }
        }
    }
    __builtin_amdgcn_wave_barrier();
    unsigned cp[13];
#pragma unroll
    for (int mi = 0; mi < 13; ++mi) { const int c = g + 4 * mi; const int ij = stair_s[c];
        const float val = sv_s[(ij >> 4) * 16 + lr] + sv_s[(16 + (ij & 15)) * 16 + lr];
        cp[mi] = (c < 50) ? ((ordf(val) & ~63u) | (unsigned)(63 - c)) : 0u; }
    float ts[16]; int ex[16];
    unsigned cthr = 0u;
#pragma unroll
    for (int r = 0; r < 16; ++r) {
        unsigned dm = cp[0] - cthr;
#pragma unroll
        for (int i = 1; i < 13; ++i) dm = max(dm, cp[i] - cthr);
        dm = max(dm, (unsigned)__builtin_amdgcn_ds_swizzle((int)dm, 0x401F)); dm = max(dm, (unsigned)__builtin_amdgcn_ds_bpermute(bp32, (int)dm));
        const unsigned mm = dm + cthr; cthr = mm;
        const int c = 63 - (int)(mm & 63u); const int ij = stair_s[c];
        ts[r] = sv_s[(ij >> 4) * 16 + lr] + sv_s[(16 + (ij & 15)) * 16 + lr];
        ex[r] = si_s[(ij >> 4) * 16 + lr] * 128 + si_s[(16 + (ij & 15)) * 16 + lr];
    }
    float mx = ts[0];
#pragma unroll
    for (int r = 1; r < 16; ++r) mx = fmaxf(mx, ts[r]);
    float sum = 0.f;
#pragma unroll
    for (int r = 0; r < 16; ++r) { ts[r] = __expf(ts[r] - mx); sum += ts[r]; }
    const float inv = 1.0f / sum;
    if (g == 0) {
        int* eo = (int*)(p.ws + WS_MIXED) + ((size_t)grp * 16 + lr) * 128 + h * 16;
        float* go = (float*)(p.ws + WS_MIXED + 8 * MB) + ((size_t)grp * 16 + lr) * 128 + h * 16;
#pragma unroll
        for (int r = 0; r < 16; r += 4) { *(int4*)(eo + r) = make_int4(ex[r], ex[r + 1], ex[r + 2], ex[r + 3]);
            *(f32x4*)(go + r) = (f32x4){ts[r] * inv, ts[r + 1] * inv, ts[r + 2] * inv, ts[r + 3] * inv}; }
    }
    __builtin_amdgcn_wave_barrier();
}
__device__ void phase_peer_topk(const Params& p, unsigned char* shm) {
    const int tid = otid(), wv = tid >> 6, h = blockIdx.x & 7, slot = blockIdx.x >> 3, nslot = gridDim.x >> 3;
    if (slot >= nslot) return;
    { const bf16_t* sk = (const bf16_t*)(p.ws + WS_SK) + (size_t)h * 2 * 128 * 128; bf16_t* sk_s = (bf16_t*)shm;
      for (int c = tid; c < 4096; c += NTHR) { const int row = c >> 4, part = c & 15; *(u32x4*)(sk_s + row * 136 + part * 8) = *(const u32x4*)(sk + (size_t)row * 128 + part * 8); }
      if (tid < 52) shm[69632 + 8 * 4096 + tid] = c_stair[tid]; }
    __syncthreads();
    for (int grp = slot * 8 + wv; grp < 1024; grp += nslot * 8) peer_topk_task(p, shm, grp, h);
}

__device__ __forceinline__ void pg_load(const unsigned char* U, const unsigned char* V, int esel, int lbase, int lane, u32x4 (&ur)[4], u32x4 (&vr)[4]) {
#pragma unroll
    for (int k = 0; k < 4; ++k) { const int id = __builtin_amdgcn_readlane(esel, lbase + k); ur[k] = *(const u32x4*)(U + (size_t)id * 1024 + lane * 16); }
#pragma unroll
    for (int k = 0; k < 4; ++k) { const int id = __builtin_amdgcn_readlane(esel, lbase + k); vr[k] = *(const u32x4*)(V + (size_t)id * 1024 + lane * 16); }
}
typedef float f32x2 __attribute__((ext_vector_type(2)));
__device__ __forceinline__ void fp8x16_pk(const u32x4 w, f32x2* f) {
#pragma unroll
    for (int q = 0; q < 4; ++q) { f[q * 2] = __builtin_amdgcn_cvt_pk_f32_fp8((int)w[q], false); f[q * 2 + 1] = __builtin_amdgcn_cvt_pk_f32_fp8((int)w[q], true); }
}
__device__ __forceinline__ void fp8x16(const u32x4 w, float* f) {
#pragma unroll
    for (int q = 0; q < 4; ++q) { const auto lo = __builtin_amdgcn_cvt_pk_f32_fp8((int)w[q], false); const auto hi = __builtin_amdgcn_cvt_pk_f32_fp8((int)w[q], true);
        f[q * 4] = lo[0]; f[q * 4 + 1] = lo[1]; f[q * 4 + 2] = hi[0]; f[q * 4 + 3] = hi[1]; }
}
__device__ __forceinline__ void pg_comp(const u32x4 (&ur)[4], const u32x4 (&vr)[4], const float* xf, float* acc, float gsel, int lbase, int lane) {
    const bool b5 = lane & 32, b4 = lane & 16;
    const int kmine = ((lane >> 5) & 1) * 2 + ((lane >> 4) & 1);
    float d[4];
#pragma unroll
    for (int k = 0; k < 4; ++k) { float uf[16]; fp8x16(ur[k], uf); float s = 0.f;
#pragma unroll
        for (int i = 0; i < 16; ++i) s += uf[i] * xf[i];
        d[k] = s; }
    float r2[2], r1;
#pragma unroll
    for (int i = 0; i < 2; ++i) { const float a = b5 ? d[i + 2] : d[i], bb = b5 ? d[i] : d[i + 2]; r2[i] = a + __shfl_xor(bb, 32); }
    { const float a = b4 ? r2[1] : r2[0], bb = b4 ? r2[0] : r2[1]; r1 = a + __shfl_xor(bb, 16); }
    r1 += __shfl_xor(r1, 8); r1 += __shfl_xor(r1, 4); r1 += __shfl_xor(r1, 2); r1 += __shfl_xor(r1, 1);
    r1 *= (1.0f / 256.0f);
    const float gt = __shfl(gsel, lbase + kmine);
    const float wgt = gt * gelu_erf(r1) * (1.0f / 64.0f);
#pragma unroll
    for (int k = 0; k < 4; ++k) { const float wk = __int_as_float(__builtin_amdgcn_readlane(__float_as_int(wgt), ((k >> 1) & 1) * 32 + (k & 1) * 16));
        float vf[16]; fp8x16(vr[k], vf);
#pragma unroll
        for (int i = 0; i < 16; ++i) acc[i] += wk * vf[i]; }
}
__device__ void phase_peer_gather(const Params& p, float* dst) {
    const int lane = otid() & 63, wg = blockIdx.x * 8 + (otid() >> 6), nw = gridDim.x * 8;
    const unsigned char* U = p.ws + WS_U; const unsigned char* V = p.ws + WS_V;
    const bf16_t* xn = (const bf16_t*)(p.ws + WS_XN);
    const int* eid = (const int*)(p.ws + WS_MIXED); const float* gate = (const float*)(p.ws + WS_MIXED + 8 * MB);
    for (int tok = wg; tok < T_; tok += nw) {
        float xf[16];
        { const u32x4* xp = (const u32x4*)(xn + (size_t)tok * 1024 + lane * 16); unpack8(xp[0], xf); unpack8(xp[1], xf + 8); }
        const int e0 = eid[(size_t)tok * 128 + lane], e1 = eid[(size_t)tok * 128 + 64 + lane];
        const float g0 = gate[(size_t)tok * 128 + lane], g1 = gate[(size_t)tok * 128 + 64 + lane];
        float acc[16];
#pragma unroll
        for (int i = 0; i < 16; ++i) acc[i] = 0.f;
        u32x4 ua[4], va[4], ub[4], vb[4];
        pg_load(U, V, e0, 0, lane, ua, va);
#pragma unroll 1
        for (int bi = 0; bi < 32; bi += 2) {
            pg_load(U, V, (bi + 1 < 16) ? e0 : e1, ((bi + 1) & 15) * 4, lane, ub, vb);
            pg_comp(ua, va, xf, acc, (bi < 16) ? g0 : g1, (bi & 15) * 4, lane);
            if (bi + 2 < 32) pg_load(U, V, (bi + 2 < 16) ? e0 : e1, ((bi + 2) & 15) * 4, lane, ua, va);
            pg_comp(ub, vb, xf, acc, (bi + 1 < 16) ? g0 : g1, ((bi + 1) & 15) * 4, lane);
        }
        const float* op = p.out + (size_t)tok * 1024 + lane * 16; float* dp = dst + (size_t)tok * 1024 + lane * 16;
#pragma unroll
        for (int q4 = 0; q4 < 4; ++q4) { f32x4 o = *(const f32x4*)(op + q4 * 4);
            o[0] += acc[q4 * 4]; o[1] += acc[q4 * 4 + 1]; o[2] += acc[q4 * 4 + 2]; o[3] += acc[q4 * 4 + 3]; *(f32x4*)(dp + q4 * 4) = o; }
    }
}

__device__ __forceinline__ void pu_compute(const u32x4 (&ur)[8], const u32x4 xa, const u32x4 xb, float gs0, float gs1, float gs2, float gs3, float gs4, float gs5, float gs6, float gs7, int pos0, int pos1, int pos2, int pos3, int pos4, int pos5, int pos6, int pos7, float* wts, int lane) {
    const bool b5 = lane & 32, b4 = lane & 16, b3 = lane & 8;
    float xf[16]; unpack8(xa, xf); unpack8(xb, xf + 8);
    float d[8];
#pragma unroll
    for (int k = 0; k < 8; ++k) { float uf[16]; fp8x16(ur[k], uf); float sacc = 0.f;
#pragma unroll
        for (int i = 0; i < 16; ++i) sacc += uf[i] * xf[i];
        d[k] = sacc; }
    float r4[4], r2[2], r1;
#pragma unroll
    for (int i = 0; i < 4; ++i) { const float a = b5 ? d[i + 4] : d[i], bb = b5 ? d[i] : d[i + 4]; r4[i] = a + __shfl_xor(bb, 32); }
#pragma unroll
    for (int i = 0; i < 2; ++i) { const float a = b4 ? r4[i + 2] : r4[i], bb = b4 ? r4[i] : r4[i + 2]; r2[i] = a + __shfl_xor(bb, 16); }
    { const float a = b3 ? r2[1] : r2[0], bb = b3 ? r2[0] : r2[1]; r1 = a + __shfl_xor(bb, 8); }
    r1 += __shfl_xor(r1, 4); r1 += __shfl_xor(r1, 2); r1 += __shfl_xor(r1, 1);
    r1 *= (1.0f / 256.0f);
    const float gt = b5 ? (b4 ? (b3 ? gs7 : gs6) : (b3 ? gs5 : gs4)) : (b4 ? (b3 ? gs3 : gs2) : (b3 ? gs1 : gs0));
    const int ps = b5 ? (b4 ? (b3 ? pos7 : pos6) : (b3 ? pos5 : pos4)) : (b4 ? (b3 ? pos3 : pos2) : (b3 ? pos1 : pos0));
    const float w = gt * gelu_erf(r1) * (1.0f / 64.0f);
    if ((lane & 7) == 0 && ps >= 0) wts[ps] = w;
}
__device__ void phase_peer_u(const Params& p) {
    const int tid = otid(), lane = tid & 63, wv = tid >> 6;
    int bid = blockIdx.x; asm volatile("" : "+s"(bid));
    const int xs = bid & 7, slot = bid >> 3, nslot = gridDim.x >> 3;
    if (slot >= nslot) return;
    const int nwx = nslot * 8;
    const unsigned char* U = p.ws + WS_U; const bf16_t* xn = (const bf16_t*)(p.ws + WS_XN);
    const int* eid = (const int*)(p.ws + WS_MIXED); const float* gate = (const float*)(p.ws + WS_MIXED + 8 * MB);
    float* wts = (float*)(p.ws + WS_PROJ);
    int ntok = slot * 8 + wv, ctok = -1;
    int ne0 = -1, ne1 = -1, ce0 = -1, ce1 = -1; float ng0 = 0.f, ng1 = 0.f, cg0 = 0.f, cg1 = 0.f; u32x4 nxa = {0u, 0u, 0u, 0u}, nxb = nxa, cxa = nxa, cxb = nxa;
    unsigned long long m0 = 0ull, m1 = 0ull;
#define PU_LOADTOK() do { if (ntok < T_) { ne0 = eid[(size_t)ntok * 128 + lane]; ne1 = eid[(size_t)ntok * 128 + 64 + lane]; ng0 = gate[(size_t)ntok * 128 + lane]; ng1 = gate[(size_t)ntok * 128 + 64 + lane]; \
            const u32x4* xp_ = (const u32x4*)(xn + (size_t)ntok * 1024 + lane * 16); nxa = xp_[0]; nxb = xp_[1]; } } while (0)
#define PU_POP(I_, G_, P_) do { \
            if (m0) { const int l = __builtin_ctzll(m0); m0 &= m0 - 1ull; I_ = __builtin_amdgcn_readlane(ce0, l); G_ = __int_as_float(__builtin_amdgcn_readlane(__float_as_int(cg0), l)); P_ = ctok * 128 + l; last_ = I_; } \
            else if (m1) { const int l = __builtin_ctzll(m1); m1 &= m1 - 1ull; I_ = __builtin_amdgcn_readlane(ce1, l); G_ = __int_as_float(__builtin_amdgcn_readlane(__float_as_int(cg1), l)); P_ = ctok * 128 + 64 + l; last_ = I_; } \
            else { I_ = last_; G_ = 0.f; P_ = -1; } } while (0)
#define PU_NEXT(HAS, ID, GS, POS, XA, XB) do { HAS = true; \
        while ((m0 | m1) == 0ull) { if (ntok >= T_) { HAS = false; break; } \
            ctok = ntok; ce0 = ne0; ce1 = ne1; cg0 = ng0; cg1 = ng1; cxa = nxa; cxb = nxb; \
            m0 = __ballot((ce0 >> 11) == xs); m1 = __ballot((ce1 >> 11) == xs); ntok += nwx; PU_LOADTOK(); } \
        if (HAS) { int last_ = 0; \
            PU_POP(ID##0, GS##0, POS##0); PU_POP(ID##1, GS##1, POS##1); PU_POP(ID##2, GS##2, POS##2); PU_POP(ID##3, GS##3, POS##3); PU_POP(ID##4, GS##4, POS##4); PU_POP(ID##5, GS##5, POS##5); PU_POP(ID##6, GS##6, POS##6); PU_POP(ID##7, GS##7, POS##7); \
          XA = cxa; XB = cxb; } } while (0)
#define PU_ROWS(ID, UR) do { UR[0] = *(const u32x4*)(U + (size_t)ID##0 * 1024 + lane * 16); UR[1] = *(const u32x4*)(U + (size_t)ID##1 * 1024 + lane * 16); UR[2] = *(const u32x4*)(U + (size_t)ID##2 * 1024 + lane * 16); UR[3] = *(const u32x4*)(U + (size_t)ID##3 * 1024 + lane * 16); UR[4] = *(const u32x4*)(U + (size_t)ID##4 * 1024 + lane * 16); UR[5] = *(const u32x4*)(U + (size_t)ID##5 * 1024 + lane * 16); UR[6] = *(const u32x4*)(U + (size_t)ID##6 * 1024 + lane * 16); UR[7] = *(const u32x4*)(U + (size_t)ID##7 * 1024 + lane * 16); } while (0)
    PU_LOADTOK();
    int ida0 = 0, idb0 = 0, posa0 = -1, posb0 = -1, ida1 = 0, idb1 = 0, posa1 = -1, posb1 = -1, ida2 = 0, idb2 = 0, posa2 = -1, posb2 = -1, ida3 = 0, idb3 = 0, posa3 = -1, posb3 = -1, ida4 = 0, idb4 = 0, posa4 = -1, posb4 = -1, ida5 = 0, idb5 = 0, posa5 = -1, posb5 = -1, ida6 = 0, idb6 = 0, posa6 = -1, posb6 = -1, ida7 = 0, idb7 = 0, posa7 = -1, posb7 = -1;
    float gsa0 = 0.f, gsb0 = 0.f, gsa1 = 0.f, gsb1 = 0.f, gsa2 = 0.f, gsb2 = 0.f, gsa3 = 0.f, gsb3 = 0.f, gsa4 = 0.f, gsb4 = 0.f, gsa5 = 0.f, gsb5 = 0.f, gsa6 = 0.f, gsb6 = 0.f, gsa7 = 0.f, gsb7 = 0.f; u32x4 xaa = cxa, xab = cxa, xba = cxa, xbb = cxa, ua[8], ub[8];
    bool ha, hb;
    PU_NEXT(ha, ida, gsa, posa, xaa, xab);
    if (ha) PU_ROWS(ida, ua);
    while (ha) {
        PU_NEXT(hb, idb, gsb, posb, xba, xbb);
        if (hb) PU_ROWS(idb, ub);
        pu_compute(ua, xaa, xab, gsa0, gsa1, gsa2, gsa3, gsa4, gsa5, gsa6, gsa7, posa0, posa1, posa2, posa3, posa4, posa5, posa6, posa7, wts, lane);
        if (!hb) break;
        PU_NEXT(ha, ida, gsa, posa, xaa, xab);
        if (ha) PU_ROWS(ida, ua);
        pu_compute(ub, xba, xbb, gsb0, gsb1, gsb2, gsb3, gsb4, gsb5, gsb6, gsb7, posb0, posb1, posb2, posb3, posb4, posb5, posb6, posb7, wts, lane);
    }
#undef PU_LOADTOK
#undef PU_NEXT
#undef PU_POP
#undef PU_ROWS
}
__device__ __forceinline__ void peer_sorted_token(const Params& p, int tok, int lane, int& e0, int& e1, float& g0, float& g1) {
    const int* eid = (const int*)(p.ws + WS_MIXED); const float* gate = (const float*)(p.ws + WS_MIXED + 8 * MB);
    e0 = eid[(size_t)tok * 128 + lane]; e1 = eid[(size_t)tok * 128 + 64 + lane];
    g0 = gate[(size_t)tok * 128 + lane]; g1 = gate[(size_t)tok * 128 + 64 + lane];
    unsigned k0 = ((unsigned)e0 << 7) | (unsigned)lane, k1 = ((unsigned)e1 << 7) | (unsigned)(64 + lane);
#pragma unroll
    for (int k = 2; k <= 128; k <<= 1) {
#pragma unroll
        for (int j = k >> 1; j >= 1; j >>= 1) {
            if (j == 64) { const unsigned lo = min(k0, k1), hi = max(k0, k1); k0 = lo; k1 = hi; }
            else { const unsigned o0 = (unsigned)__shfl_xor((int)k0, j), o1 = (unsigned)__shfl_xor((int)k1, j);
                const bool lower = (lane & j) == 0, up0 = (lane & k) == 0, up1 = ((64 + lane) & k) == 0;
                k0 = (lower == up0) ? min(k0, o0) : max(k0, o0); k1 = (lower == up1) ? min(k1, o1) : max(k1, o1); }
        }
    }
    const int s0 = (int)(k0 & 127u), s1 = (int)(k1 & 127u);
    const float ga0 = __shfl(g0, s0 & 63), gb0 = __shfl(g1, s0 & 63), ga1 = __shfl(g0, s1 & 63), gb1 = __shfl(g1, s1 & 63);
    e0 = (int)(k0 >> 7); e1 = (int)(k1 >> 7); g0 = (s0 < 64) ? ga0 : gb0; g1 = (s1 < 64) ? ga1 : gb1;
    int* eidw = (int*)(p.ws + WS_MIXED); eidw[(size_t)tok * 128 + lane] = e0; eidw[(size_t)tok * 128 + 64 + lane] = e1;
}
__device__ void phase_peer_u_tok(const Params& p) {
    const int lane = otid() & 63, wg = blockIdx.x * 8 + (otid() >> 6), nw = gridDim.x * 8;
    const unsigned char* U = p.ws + WS_U; const bf16_t* xn = (const bf16_t*)(p.ws + WS_XN);
    float* wts = (float*)(p.ws + WS_PROJ);
    const bool b5 = lane & 32, b4 = lane & 16, b3 = lane & 8;
    const int kmine = ((lane >> 5) & 1) * 4 + ((lane >> 4) & 1) * 2 + ((lane >> 3) & 1);
    int rnd = 0;
    for (int tbase = wg; tbase < T_; tbase += 4 * nw, ++rnd) {
        const int rev = (rnd & 1) ? 15 : 0;
        const bool has0 = tbase + 0 * nw < T_; const int tok0 = has0 ? tbase + 0 * nw : tbase;
        const bool has1 = tbase + 1 * nw < T_; const int tok1 = has1 ? tbase + 1 * nw : tbase;
        const bool has2 = tbase + 2 * nw < T_; const int tok2 = has2 ? tbase + 2 * nw : tbase;
        const bool has3 = tbase + 3 * nw < T_; const int tok3 = has3 ? tbase + 3 * nw : tbase;
        u32x4 xa0, xb0; { const u32x4* xp = (const u32x4*)(xn + (size_t)tok0 * 1024 + lane * 16); xa0 = xp[0]; xb0 = xp[1]; }
        u32x4 xa1, xb1; { const u32x4* xp = (const u32x4*)(xn + (size_t)tok1 * 1024 + lane * 16); xa1 = xp[0]; xb1 = xp[1]; }
        u32x4 xa2, xb2; { const u32x4* xp = (const u32x4*)(xn + (size_t)tok2 * 1024 + lane * 16); xa2 = xp[0]; xb2 = xp[1]; }
        u32x4 xa3, xb3; { const u32x4* xp = (const u32x4*)(xn + (size_t)tok3 * 1024 + lane * 16); xa3 = xp[0]; xb3 = xp[1]; }
        int e00, e01; float g00, g01; peer_sorted_token(p, tok0, lane, e00, e01, g00, g01);
        int e10, e11; float g10, g11; if (has1) peer_sorted_token(p, tok1, lane, e10, e11, g10, g11); else { e10 = e00; e11 = e01; g10 = 0.f; g11 = 0.f; }
        int e20, e21; float g20, g21; if (has2) peer_sorted_token(p, tok2, lane, e20, e21, g20, g21); else { e20 = e00; e21 = e01; g20 = 0.f; g21 = 0.f; }
        int e30, e31; float g30, g31; if (has3) peer_sorted_token(p, tok3, lane, e30, e31, g30, g31); else { e30 = e00; e31 = e01; g30 = 0.f; g31 = 0.f; }
        u32x4 ua[8], ub[8];
#define PUT_LD(bi_, U_, E0_, E1_) do { const int es_ = ((bi_) < 8) ? E0_ : E1_; _Pragma("unroll") for (int k = 0; k < 8; ++k) { const int id = __builtin_amdgcn_readlane(es_, ((bi_) & 7) * 8 + k); U_[k] = *(const u32x4*)(U + (size_t)id * 1024 + lane * 16); } } while (0)
#define PUT_CP(bi_, U_, XA_, XB_, G0_, G1_, TOK_, ST_) do { float xf_[16]; unpack8(XA_, xf_); unpack8(XB_, xf_ + 8); f32x2 x2_[8]; _Pragma("unroll") for (int i = 0; i < 8; ++i) x2_[i] = (f32x2){xf_[2 * i], xf_[2 * i + 1]}; float d[8]; _Pragma("unroll") for (int k = 0; k < 8; ++k) { f32x2 uf[8]; fp8x16_pk(U_[k], uf); f32x2 sacc = uf[0] * x2_[0]; _Pragma("unroll") for (int i = 1; i < 8; ++i) sacc = __builtin_elementwise_fma(uf[i], x2_[i], sacc); d[k] = sacc[0] + sacc[1]; } \
            float r4[4], r2[2], r1; \
            _Pragma("unroll") for (int i = 0; i < 4; ++i) { const float a = b5 ? d[i + 4] : d[i], bb = b5 ? d[i] : d[i + 4]; r4[i] = a + __shfl_xor(bb, 32); } \
            _Pragma("unroll") for (int i = 0; i < 2; ++i) { const float a = b4 ? r4[i + 2] : r4[i], bb = b4 ? r4[i] : r4[i + 2]; r2[i] = a + __shfl_xor(bb, 16); } \
            { const float a = b3 ? r2[1] : r2[0], bb = b3 ? r2[0] : r2[1]; r1 = a + __shfl_xor(bb, 8); } \
            r1 += __shfl_xor(r1, 4); r1 += __shfl_xor(r1, 2); r1 += __shfl_xor(r1, 1); r1 *= (1.0f / 256.0f); \
            const float gt = __shfl(((bi_) < 8) ? G0_ : G1_, ((bi_) & 7) * 8 + kmine); \
            if ((lane & 7) == 0 && (ST_)) wts[(size_t)(TOK_) * 128 + (bi_) * 8 + kmine] = gt * gelu_erf(r1) * (1.0f / 64.0f); } while (0)
        PUT_LD(0 ^ rev, ua, e00, e01);
#pragma unroll 1
        for (int bi = 0; bi < 16; ++bi) {
            PUT_LD(bi ^ rev, ub, e10, e11);
            PUT_CP(bi ^ rev, ua, xa0, xb0, g00, g01, tok0, has0);
            PUT_LD(bi ^ rev, ua, e20, e21);
            PUT_CP(bi ^ rev, ub, xa1, xb1, g10, g11, tok1, has1);
            PUT_LD(bi ^ rev, ub, e30, e31);
            PUT_CP(bi ^ rev, ua, xa2, xb2, g20, g21, tok2, has2);
            if (bi + 1 < 16) PUT_LD((bi + 1) ^ rev, ua, e00, e01);
            PUT_CP(bi ^ rev, ub, xa3, xb3, g30, g31, tok3, has3);
        }
#undef PUT_LD
#undef PUT_CP
    }
}
__device__ void phase_peer_v(const Params& p) {
    const int lane = otid() & 63, wg = blockIdx.x * 8 + (otid() >> 6), nw = gridDim.x * 8;
    const unsigned char* V = p.ws + WS_V;
    const int* eid = (const int*)(p.ws + WS_MIXED); const float* wts = (const float*)(p.ws + WS_PROJ);
    int rnd = 0;
    for (int tbase = wg; tbase < T_; tbase += 4 * nw, ++rnd) {
        const int rev = (rnd & 1) ? 31 : 0;
        const bool has0 = tbase + 0 * nw < T_; const int tok0 = has0 ? tbase + 0 * nw : tbase;
        const bool has1 = tbase + 1 * nw < T_; const int tok1 = has1 ? tbase + 1 * nw : tbase;
        const bool has2 = tbase + 2 * nw < T_; const int tok2 = has2 ? tbase + 2 * nw : tbase;
        const bool has3 = tbase + 3 * nw < T_; const int tok3 = has3 ? tbase + 3 * nw : tbase;
        const int e00 = eid[(size_t)tok0 * 128 + lane], e01 = eid[(size_t)tok0 * 128 + 64 + lane]; const float w00 = wts[(size_t)tok0 * 128 + lane], w01 = wts[(size_t)tok0 * 128 + 64 + lane];
        f32x2 acc0[8];
#pragma unroll
        for (int i = 0; i < 8; ++i) acc0[i] = (f32x2){0.f, 0.f};
        const int e10 = eid[(size_t)tok1 * 128 + lane], e11 = eid[(size_t)tok1 * 128 + 64 + lane]; const float w10 = wts[(size_t)tok1 * 128 + lane], w11 = wts[(size_t)tok1 * 128 + 64 + lane];
        f32x2 acc1[8];
#pragma unroll
        for (int i = 0; i < 8; ++i) acc1[i] = (f32x2){0.f, 0.f};
        const int e20 = eid[(size_t)tok2 * 128 + lane], e21 = eid[(size_t)tok2 * 128 + 64 + lane]; const float w20 = wts[(size_t)tok2 * 128 + lane], w21 = wts[(size_t)tok2 * 128 + 64 + lane];
        f32x2 acc2[8];
#pragma unroll
        for (int i = 0; i < 8; ++i) acc2[i] = (f32x2){0.f, 0.f};
        const int e30 = eid[(size_t)tok3 * 128 + lane], e31 = eid[(size_t)tok3 * 128 + 64 + lane]; const float w30 = wts[(size_t)tok3 * 128 + lane], w31 = wts[(size_t)tok3 * 128 + 64 + lane];
        f32x2 acc3[8];
#pragma unroll
        for (int i = 0; i < 8; ++i) acc3[i] = (f32x2){0.f, 0.f};
        u32x4 va[4], vb[4];
#define PV_LD(bi_, V_, E0_, E1_) do { const int es_ = ((bi_) < 16) ? E0_ : E1_; _Pragma("unroll") for (int k = 0; k < 4; ++k) { const int id = __builtin_amdgcn_readlane(es_, ((bi_) & 15) * 4 + k); V_[k] = *(const u32x4*)(V + (size_t)id * 1024 + lane * 16); } } while (0)
#define PV_CP(bi_, V_, W0_, W1_, ACC_) do { const float ws_ = ((bi_) < 16) ? W0_ : W1_; _Pragma("unroll") for (int k = 0; k < 4; ++k) { const float wk = __int_as_float(__builtin_amdgcn_readlane(__float_as_int(ws_), ((bi_) & 15) * 4 + k)); \
            f32x2 vf[8]; fp8x16_pk(V_[k], vf); const f32x2 wk2 = (f32x2){wk, wk}; _Pragma("unroll") for (int i = 0; i < 8; ++i) ACC_[i] = __builtin_elementwise_fma(vf[i], wk2, ACC_[i]); } } while (0)
        PV_LD(0 ^ rev, va, e00, e01);
#pragma unroll 1
        for (int bi = 0; bi < 32; ++bi) {
            PV_LD(bi ^ rev, vb, e10, e11);
            PV_CP(bi ^ rev, va, w00, w01, acc0);
            PV_LD(bi ^ rev, va, e20, e21);
            PV_CP(bi ^ rev, vb, w10, w11, acc1);
            PV_LD(bi ^ rev, vb, e30, e31);
            PV_CP(bi ^ rev, va, w20, w21, acc2);
            if (bi + 1 < 32) PV_LD((bi + 1) ^ rev, va, e00, e01);
            PV_CP(bi ^ rev, vb, w30, w31, acc3);
        }
#undef PV_LD
#undef PV_CP
        if (has0) { float* op = p.out + (size_t)tok0 * 1024 + lane * 16;
#pragma unroll
          for (int q4 = 0; q4 < 4; ++q4) { f32x4 o = *(const f32x4*)(op + q4 * 4);
              o[0] += acc0[q4 * 2][0]; o[1] += acc0[q4 * 2][1]; o[2] += acc0[q4 * 2 + 1][0]; o[3] += acc0[q4 * 2 + 1][1]; *(f32x4*)(op + q4 * 4) = o; } }
        if (has1) { float* op = p.out + (size_t)tok1 * 1024 + lane * 16;
#pragma unroll
          for (int q4 = 0; q4 < 4; ++q4) { f32x4 o = *(const f32x4*)(op + q4 * 4);
              o[0] += acc1[q4 * 2][0]; o[1] += acc1[q4 * 2][1]; o[2] += acc1[q4 * 2 + 1][0]; o[3] += acc1[q4 * 2 + 1][1]; *(f32x4*)(op + q4 * 4) = o; } }
        if (has2) { float* op = p.out + (size_t)tok2 * 1024 + lane * 16;
#pragma unroll
          for (int q4 = 0; q4 < 4; ++q4) { f32x4 o = *(const f32x4*)(op + q4 * 4);
              o[0] += acc2[q4 * 2][0]; o[1] += acc2[q4 * 2][1]; o[2] += acc2[q4 * 2 + 1][0]; o[3] += acc2[q4 * 2 + 1][1]; *(f32x4*)(op + q4 * 4) = o; } }
        if (has3) { float* op = p.out + (size_t)tok3 * 1024 + lane * 16;
#pragma unroll
          for (int q4 = 0; q4 < 4; ++q4) { f32x4 o = *(const f32x4*)(op + q4 * 4);
              o[0] += acc3[q4 * 2][0]; o[1] += acc3[q4 * 2][1]; o[2] += acc3[q4 * 2 + 1][0]; o[3] += acc3[q4 * 2 + 1][1]; *(f32x4*)(op + q4 * 4) = o; } }
    }
}

constexpr size_t WS_BAR = 239 * MB;
#define XB_TMO      128
#define XB_XCNT(j)  (256  + 64 * (j))
#define XB_XSUB(j)  (1280 + 64 * (j))
#define XB_XGEN(j)  (2304 + 64 * (j))
#define XB_TOP      3328
#define XB_TOPGEN   3392
#define XCD_BAR_WORDS 3456
#define XB_SPIN_CAP (1u << 18)
__device__ __forceinline__ unsigned xb_ld(unsigned* p)              { return __hip_atomic_load(p, __ATOMIC_RELAXED, __HIP_MEMORY_SCOPE_AGENT); }
__device__ __forceinline__ unsigned xb_add(unsigned* p, unsigned v) { return __hip_atomic_fetch_add(p, v, __ATOMIC_RELAXED, __HIP_MEMORY_SCOPE_AGENT); }
__device__ __forceinline__ unsigned xb_xcc_id() { return (unsigned)__builtin_amdgcn_s_getreg((3 << 11) | 20) & 0xFu; }
#define XB_SPIN(cond, bar) do { unsigned _sp = 0; while (cond) { __builtin_amdgcn_s_sleep(1); \
    if ((++_sp & 255u) == 0u) { if (xb_ld(&(bar)[XB_TMO])) break; if (_sp > XB_SPIN_CAP) { atomicAdd(&(bar)[XB_TMO], 1u); break; } } } } while (0)
struct XcdBarrier { unsigned* bar; unsigned x; volatile LAS unsigned* st; };
__device__ __forceinline__ XcdBarrier xcd_barrier_post(unsigned* bar, volatile LAS unsigned* st) {
    XcdBarrier b; b.bar = bar; b.x = xb_xcc_id(); b.st = st;
    if (threadIdx.x == 0) (void)xb_add(&bar[XB_XCNT(b.x)], 1u);
    return b;
}
__device__ __forceinline__ void xcd_barrier_complete(unsigned* bar, unsigned x, unsigned& nloc, unsigned& nx) {
    const unsigned G = gridDim.x * gridDim.y * gridDim.z;
    unsigned sum, cnt, mine, sp = 0u;
    for (;;) {
        sum = 0u; cnt = 0u; mine = 0u;
#pragma unroll
        for (unsigned j = 0; j < 16; ++j) { const unsigned c = xb_ld(&bar[XB_XCNT(j)]); sum += c; cnt += (c > 0u) ? 1u : 0u; mine = (j == x) ? c : mine; }
        if (sum == G) break;
        __builtin_amdgcn_s_sleep(1);
        if ((++sp & 255u) == 0u) { if (xb_ld(&bar[XB_TMO])) break; if (sp > XB_SPIN_CAP) { atomicAdd(&bar[XB_TMO], 1u); break; } }
    }
    nloc = mine > 0u ? mine : 1u; nx = cnt > 0u ? cnt : 1u;
}
__device__ __forceinline__ void xcd_barrier(const XcdBarrier& b) {
    asm volatile("s_waitcnt vmcnt(0)" ::: "memory");
    __syncthreads();
    if (threadIdx.x == 0) {
        unsigned* bar = b.bar;
        __builtin_amdgcn_s_waitcnt(0);
        unsigned nloc = b.st[0], nx = b.st[1];
        if (nloc == 0u) { xcd_barrier_complete(bar, b.x, nloc, nx); b.st[0] = nloc; b.st[1] = nx; }
        const unsigned old = xb_add(&bar[XB_XSUB(b.x)], 1u);
        const unsigned gen = old / nloc;
        if (old + 1u == (gen + 1u) * nloc) {
            __builtin_amdgcn_fence(__ATOMIC_RELEASE, "agent");
            asm volatile("s_waitcnt vmcnt(0)" ::: "memory");
            const unsigned og = xb_add(&bar[XB_TOP], 1u);
            const unsigned tg = og / nx;
            if (og + 1u == (tg + 1u) * nx) xb_add(&bar[XB_TOPGEN], 1u);
            else XB_SPIN(xb_ld(&bar[XB_TOPGEN]) == tg, bar);
            __builtin_amdgcn_fence(__ATOMIC_ACQUIRE, "agent");
            xb_add(&bar[XB_XGEN(b.x)], 1u);
            asm volatile("s_waitcnt vmcnt(0)" ::: "memory");
        } else {
            XB_SPIN(xb_ld(&bar[XB_XGEN(b.x)]) == gen, bar);
            __builtin_amdgcn_fence(__ATOMIC_ACQUIRE, "agent");
            asm volatile("s_waitcnt vmcnt(0)" ::: "memory");
        }
    }
    __syncthreads();
}
__device__ __forceinline__ void seam(const XcdBarrier& xb, int k) {
    asm volatile("" : "+s"(k));
    if (k < 0) cg::this_grid().sync();
    else xcd_barrier(xb);
}

__global__ void __launch_bounds__(NTHR, 2) fwd_kernel(Params p) {
    extern __shared__ __attribute__((aligned(16))) unsigned char shm[];
    __shared__ uint4 xb_words;
    if (threadIdx.x == 0) xb_words = make_uint4(0u, 0u, 0u, 0u);
    __syncthreads();
    const XcdBarrier xb = xcd_barrier_post((unsigned*)(p.ws + WS_BAR), (volatile LAS unsigned*)&xb_words);
#ifndef PH_MASK
#define PH_MASK 0x7ff
#endif
#define PH_ON(n) ((PH_MASK >> (n)) & 1)
#define PHASE(n) if (PH_ON(n) && (n) >= p.ph_lo && (n) < p.ph_hi && (((n) > p.ph_lo) ? (seam(xb, (n)), true) : true))
    PHASE(0) {
#pragma unroll 1
        for (int rep = 0; rep < REP0; ++rep) { if (rep) cg::this_grid().sync();   phase_prep(p, shm); } }
    PHASE(1) for (int rep = 0; rep < REPG; ++rep) { if (rep) cg::this_grid().sync();   pg8::Gemm gm{(const bf16_t*)(p.ws + WS_XN), (const bf16_t*)(p.ws + WS_WIN), T_, NPROJ, D_}; pg8::StaticOrder so; so.init(T_, NPROJ, gridDim.x, blockIdx.x);
               pg8::EpiBf16Out ep{(bf16_t*)(p.ws + WS_PROJ), NPROJ}; pg8::gemm_phase((LAS unsigned char*)shm, gm, so, ep); }
    PHASE(2) phase_mixprep(p, shm);
    PHASE(3) { gla_scan(p);
#pragma unroll 1
        for (int rep = 0; rep < REP3; ++rep) { if (rep) cg::this_grid().sync();   phase_moba(p, shm); } }
    PHASE(4) {
#pragma unroll 1
        for (int rep = 0; rep < REP4; ++rep) { if (rep) cg::this_grid().sync();   phase_gla_out(p); } }
    PHASE(5) for (int rep = 0; rep < REPG; ++rep) { if (rep) cg::this_grid().sync();   pg8::Gemm gm{(const bf16_t*)(p.ws + WS_MIXED), (const bf16_t*)(p.ws + WS_WOUT), T_, D_, D_}; pg8::StaticOrder so; so.init(T_, D_, gridDim.x, blockIdx.x);
               pg8::EpiResF32 ep{p.out, p.x, D_}; pg8::gemm_phase((LAS unsigned char*)shm, gm, so, ep); }
    PHASE(6) {
#pragma unroll 1
        for (int rep = 0; rep < REP4; ++rep) { if (rep) cg::this_grid().sync();   rmsnorm_rows<false, true>(p.out, p.norm2_w, (bf16_t*)(p.ws + WS_XN), nullptr, nullptr, (unsigned*)(p.ws + WS_XQ8), (float*)(p.ws + WS_SX)); } }
    PHASE(7) for (int rep = 0; rep < REPG; ++rep) { if (rep) cg::this_grid().sync();   pg8::Gemm gm{(const bf16_t*)(p.ws + WS_XQ8), (const bf16_t*)(p.ws + WS_WQ8), T_, 2048, D_ / 2}; pg8::StaticOrder so; so.init(T_, 2048, gridDim.x, blockIdx.x);
               pg8::EpiBf16OutI8 ep{(bf16_t*)(p.ws + WS_PROJ), 2048, (const float*)(p.ws + WS_SX), (const float*)(p.ws + WS_SW)}; pg8::gemm_phase((LAS unsigned char*)shm, gm, so, ep); }
    PHASE(8) {
#pragma unroll 1
        for (int rep = 0; rep < REP8; ++rep) { if (rep) cg::this_grid().sync();   phase_peer_topk(p, shm); } }
#if SPLIT_GATHER
#if SPLIT_GATHER == 2
    PHASE(9) phase_peer_u_tok(p);
#else
    PHASE(9) phase_peer_u(p);
#endif
    PHASE(10) phase_peer_v(p);
#else
    PHASE(9) phase_peer_gather(p, p.out);
#endif
}

extern "C" void kernel_launch(void* const* d_in, const int* in_sizes, int n_in, void* d_out, int out_size, void* d_ws, size_t ws_size, hipStream_t stream) {
    static int grid = 0;
    if (grid == 0) {
        int dev = 0, cus = 0, per_cu = 0;
        (void)hipGetDevice(&dev);
        (void)hipDeviceGetAttribute(&cus, hipDeviceAttributeMultiprocessorCount, dev);
        if (hipFuncSetAttribute((const void*)fwd_kernel, hipFuncAttributeMaxDynamicSharedMemorySize, LDS_BYTES) != hipSuccess) fprintf(stderr, "hipFuncSetAttribute failed\n");
        (void)hipOccupancyMaxActiveBlocksPerMultiprocessor(&per_cu, (const void*)fwd_kernel, NTHR, LDS_BYTES);
        if (per_cu < 1) per_cu = 1;
        grid = cus * 1;
        (void)hipGetLastError();
        if (ws_size < WS_END) fprintf(stderr, "workspace too small: %zu\n", ws_size);
    }
    Params p{};
    p.x = (const float*)d_in[0]; p.norm1_w = (const float*)d_in[1]; p.w_in = (const float*)d_in[2]; p.w_alpha = (const float*)d_in[3]; p.b_alpha = (const float*)d_in[4];
    p.gla_onw = (const float*)d_in[5]; p.mqw = (const float*)d_in[6]; p.mkw = (const float*)d_in[7]; p.mix_scale = (const float*)d_in[8]; p.w_out = (const float*)d_in[9];
    p.norm2_w = (const float*)d_in[10]; p.w_query = (const float*)d_in[11]; p.subkeys = (const float*)d_in[12]; p.peer_u = (const float*)d_in[13]; p.peer_v = (const float*)d_in[14];
    p.out = (float*)d_out; p.ws = (unsigned char*)d_ws;
#if MEGA
    p.ph_lo = 0; p.ph_hi = 11;
    (void)hipMemsetAsync((unsigned char*)d_ws + WS_BAR, 0, 16384, stream);
    void* args[] = {&p};
    hipError_t e = hipLaunchCooperativeKernel((const void*)fwd_kernel, dim3(grid), dim3(NTHR), args, LDS_BYTES, stream);
    if (e != hipSuccess) fprintf(stderr, "cooperative launch failed: %s (grid %d)\n", hipGetErrorString(e), grid);
#else
    for (int ph = 0; ph < 10; ++ph) { p.ph_lo = ph; p.ph_hi = ph + 1; hipLaunchKernelGGL(fwd_kernel, dim3(grid), dim3(NTHR), LDS_BYTES, stream, p); }
#endif
}
```

```cpp
#include <hip/hip_runtime.h>
#include <hip/hip_cooperative_groups.h>
#include <cstdio>
namespace cg = cooperative_groups;

#define REP0 1
#ifndef SPLIT_GATHER
#define SPLIT_GATHER 2
#endif
#define REPG 1
#define REP4 1
#define REP3 1
#define REP8 1
#define REP9 1
#ifndef MEGA
#define MEGA 1
#endif

typedef unsigned short bf16_t;
typedef short bf16x8 __attribute__((ext_vector_type(8)));
typedef short bf16x4 __attribute__((ext_vector_type(4)));
typedef float f32x4 __attribute__((ext_vector_type(4)));
typedef unsigned u32x4 __attribute__((ext_vector_type(4)));
typedef unsigned u32x2 __attribute__((ext_vector_type(2)));
typedef int i32x4 __attribute__((ext_vector_type(4)));
#define LAS __attribute__((address_space(3)))

constexpr int T_ = 16384, D_ = 1024, S_ = 4096;
constexpr int NPROJ = 3072;
constexpr int C_GQ = 0, C_GK = 256, C_GV = 512, C_GG = 1024, C_MQ = 1536, C_MK = 2048, C_MV = 2560;
constexpr int WIN_LD = 3088;
constexpr float EPS_ = 1e-6f;
constexpr int LDS_BYTES = 131072;
constexpr int NTHR = 512;

constexpr size_t MB = 1024 * 1024;
constexpr size_t WS_WIN = 0, WS_WOUT = 6 * MB, WS_WQ = 8 * MB, WS_U = 12 * MB, WS_V = 44 * MB, WS_XN = 76 * MB,
                 WS_PROJ = 108 * MB, WS_MIXED = 204 * MB, WS_GR = 236 * MB, WS_DECAY = 237 * MB,
                 WS_ROPE = 237 * MB + 256 * 1024, WS_SK = 238 * MB + 256 * 1024, WS_END = 239 * MB;
constexpr size_t WS_WQ8 = WS_WIN, WS_SW = WS_WIN + 2 * MB, WS_SX = WS_WIN + 2 * MB + 65536, WS_XQ8 = WS_U + 16 * MB;
constexpr size_t OUT_GVT = 0, OUT_MVT = 16 * MB, OUT_KBAR = 32 * MB;

struct Params {
    const float *x, *norm1_w, *w_in, *w_alpha, *b_alpha, *gla_onw, *mqw, *mkw, *mix_scale, *w_out, *norm2_w, *w_query, *subkeys, *peer_u, *peer_v;
    float* out; unsigned char* ws; int ph_lo, ph_hi;
};

__device__ __forceinline__ bf16_t f2bf(float f) { unsigned u = __float_as_uint(f); u += 0x7FFFu + ((u >> 16) & 1u); return (bf16_t)(u >> 16); }
__device__ __forceinline__ float bf2f(bf16_t b) { return __uint_as_float(((unsigned)b) << 16); }
__device__ __forceinline__ unsigned pk2(float lo, float hi) { unsigned r; asm volatile("v_cvt_pk_bf16_f32 %0, %1, %2" : "=v"(r) : "v"(lo), "v"(hi)); return r; }
__device__ __forceinline__ float lo_f(unsigned w) { return __uint_as_float(w << 16); }
__device__ __forceinline__ float hi_f(unsigned w) { return __uint_as_float(w & 0xffff0000u); }
__device__ __forceinline__ void unpack8(const u32x4 w, float* f) { f[0] = lo_f(w.x); f[1] = hi_f(w.x); f[2] = lo_f(w.y); f[3] = hi_f(w.y); f[4] = lo_f(w.z); f[5] = hi_f(w.z); f[6] = lo_f(w.w); f[7] = hi_f(w.w); }
__device__ __forceinline__ float wave_sum(float v) { for (int o = 32; o > 0; o >>= 1) v += __shfl_xor(v, o); return v; }
__device__ __forceinline__ unsigned ordf(float f) { unsigned u = __float_as_uint(f); return (u & 0x80000000u) ? ~u : (u | 0x80000000u); }
__device__ __forceinline__ float unordf(unsigned o) { unsigned u = (o & 0x80000000u) ? (o & 0x7fffffffu) : ~o; return __uint_as_float(u); }
__device__ __forceinline__ bf16x8 as_bf16x8(u32x4 v) { union { u32x4 a; bf16x8 b; } t; t.a = v; return t.b; }
__device__ __forceinline__ bf16x8 as_bf16x8_2(u32x2 lo, u32x2 hi) { union { unsigned a[4]; bf16x8 b; } t; t.a[0] = lo.x; t.a[1] = lo.y; t.a[2] = hi.x; t.a[3] = hi.y; return t.b; }
__device__ __forceinline__ bf16x4 as_bf16x4(u32x2 v) { union { u32x2 a; bf16x4 b; } t; t.a = v; return t.b; }
__device__ __forceinline__ int otid() { int t = threadIdx.x; asm volatile("" : "+v"(t)); return t; }
__device__ __forceinline__ float gelu_erf(float v) {
    const float av = fabsf(v), t = __builtin_amdgcn_rcpf(av * 0.2316418882f + 1.0f);
    float q = t * 0.5307027145f + (-0.7265760135f); q = q * t + 0.7107068705f; q = q * t + (-0.142248368f); q = q * t + 0.127414796f; q = q * t;
    const float e = __builtin_amdgcn_exp2f((v * v) * (-0.72134752044f));
    const float m = v * (q * e);
    return v < 0.f ? m : v - m;
}
#define MFMA32(a, b, c) __builtin_amdgcn_mfma_f32_16x16x32_bf16((a), (b), (c), 0, 0, 0)
#define MFMA16(a, b, c) __builtin_amdgcn_mfma_f32_16x16x16bf16_1k((a), (b), (c), 0, 0, 0)

namespace pg8 {
constexpr int BM = 256, BK = 64, HALF = 128, HTB = HALF * BK * 2, NXCD = 8, WGM = 8;
__device__ __forceinline__ int lds_byte(int r, int c) { const int st = (r >> 4) * 2 + (c >> 5), rr = r & 15, cc = c & 31, ob = rr * 64 + cc * 2; return st * 1024 + (ob ^ (((ob >> 9) & 1) << 5)); }
__device__ __forceinline__ void stage_rc(int b, int& R, int& C) { const int st = b / 1024, sb = b % 1024, swz = sb ^ (((sb >> 9) & 1) << 5); R = (st >> 1) * 16 + swz / 64; C = (st & 1) * 32 + (swz % 64) / 2; }
__device__ __forceinline__ int perm32(int rho) { const int n = rho >> 4, i = rho & 15; return 8 * (i >> 2) + 4 * n + (i & 3); }
struct Unit { int pm, pn; };
struct Gemm { const bf16_t* A; const bf16_t* Bt; int M, N, K; };
struct StaticOrder {
    int nM, nN, nwg, G, c;
    __device__ void init(int M, int N, int G_, int c_) { nM = M / BM; nN = N / BM; nwg = nM * nN; G = G_; c = c_; }
    __device__ bool next(int i, Unit& u) const {
        const long L = (long)i * G + c; if (L >= nwg) return false;
        int wgid = (int)L; { const int q = nwg / NXCD, r = nwg % NXCD, xcd = wgid % NXCD, off = wgid / NXCD; wgid = (xcd < r ? xcd * (q + 1) : r * (q + 1) + (xcd - r) * q) + off; }
        const int nig = WGM * nN, gid = wgid / nig, fm = gid * WGM, gsz = (nM - fm) < WGM ? (nM - fm) : WGM;
        u.pm = fm + ((wgid % nig) % gsz); u.pn = (wgid % nig) / gsz; return true;
    }
};
struct EpiBf16Out {
    static constexpr bool PERM = true, I8 = false;
    bf16_t* O; int ldc;
    __device__ __forceinline__ void operator()(const f32x4 (&acc)[2][2][4][2], const Unit& u, int wr, int wc, int fr, int fq) const {
        const int row0 = u.pm * BM + wr * 64 + fr, col0 = u.pn * BM + wc * 32 + 8 * fq;
#pragma unroll
        for (int ai = 0; ai < 2; ++ai)
#pragma unroll
            for (int m = 0; m < 4; ++m) { bf16_t* rowp = O + (size_t)(row0 + ai * HALF + m * 16) * ldc + col0;
#pragma unroll
                for (int bj = 0; bj < 2; ++bj) { const f32x4 v0 = acc[ai][bj][m][0], v1 = acc[ai][bj][m][1];
                    u32x4 w; w.x = pk2(v0[0], v0[1]); w.y = pk2(v0[2], v0[3]); w.z = pk2(v1[0], v1[1]); w.w = pk2(v1[2], v1[3]);
                    *(u32x4*)(rowp + bj * HALF) = w; } }
    }
};
struct EpiResF32 {
    static constexpr bool PERM = false, I8 = false;
    float* C; const float* R; int ldc;
    __device__ __forceinline__ void operator()(const f32x4 (&acc)[2][2][4][2], const Unit& u, int wr, int wc, int fr, int fq) const {
        const int row0 = u.pm * BM + wr * 64 + fr, col0 = u.pn * BM + wc * 32 + 4 * fq;
#pragma unroll
        for (int ai = 0; ai < 2; ++ai)
#pragma unroll
            for (int m = 0; m < 4; ++m) { const size_t off = (size_t)(row0 + ai * HALF + m * 16) * ldc + col0;
#pragma unroll
                for (int bj = 0; bj < 2; ++bj)
#pragma unroll
                    for (int n = 0; n < 2; ++n) *(f32x4*)(C + off + bj * HALF + n * 16) = acc[ai][bj][m][n] + *(const f32x4*)(R + off + bj * HALF + n * 16); }
    }
};

struct EpiBf16OutI8 {
    static constexpr bool PERM = true, I8 = true;
    bf16_t* O; int ldc; const float* sx; const float* sw;
    __device__ __forceinline__ void operator()(const f32x4 (&acc)[2][2][4][2], const Unit& u, int wr, int wc, int fr, int fq) const {
        const int row0 = u.pm * BM + wr * 64 + fr, col0 = u.pn * BM + wc * 32 + 8 * fq;
        f32x4 cs[2][2];
#pragma unroll
        for (int bj = 0; bj < 2; ++bj)
#pragma unroll
            for (int n = 0; n < 2; ++n) cs[bj][n] = *(const f32x4*)(sw + col0 + bj * HALF + 4 * n);
#pragma unroll
        for (int ai = 0; ai < 2; ++ai)
#pragma unroll
            for (int m = 0; m < 4; ++m) { const int row = row0 + ai * HALF + m * 16; const float rsx = sx[row]; bf16_t* rowp = O + (size_t)row * ldc + col0;
#pragma unroll
                for (int bj = 0; bj < 2; ++bj) { const i32x4 a0 = __builtin_bit_cast(i32x4, acc[ai][bj][m][0]), a1 = __builtin_bit_cast(i32x4, acc[ai][bj][m][1]);
                    float v[8];
#pragma unroll
                    for (int j = 0; j < 4; ++j) { v[j] = (float)a0[j] * rsx * cs[bj][0][j]; v[4 + j] = (float)a1[j] * rsx * cs[bj][1][j]; }
                    u32x4 w; w.x = pk2(v[0], v[1]); w.y = pk2(v[2], v[3]); w.z = pk2(v[4], v[5]); w.w = pk2(v[6], v[7]);
                    *(u32x4*)(rowp + bj * HALF) = w; } }
    }
};
template <class Epi>
__device__ __forceinline__ void gemm_phase(LAS unsigned char* lds, const Gemm g, const StaticOrder& S, const Epi& E) {
    const int tid = threadIdx.x, wid = __builtin_amdgcn_readfirstlane(tid >> 6), lane = tid & 63, wr = wid >> 2, wc = wid & 3, fr = lane & 15, fq = lane >> 4;
    const int K = g.K, nt = K / BK;
    unsigned voffA[2], voffB[2];
#pragma unroll
    for (int i = 0; i < 2; ++i) { int R, C; stage_rc(tid * 16 + i * 8192, R, C); const int Rb = Epi::PERM ? ((R & ~31) + perm32(R & 31)) : R;
        voffA[i] = (unsigned)(R * K + C) * 2u; voffB[i] = (unsigned)(Rb * K + C) * 2u; }
    const size_t kstep = (size_t)(BK * 2);
    const size_t hstep = (size_t)HALF * K * 2;
    const size_t tstep = 2 * hstep;
    const unsigned ldsw = (unsigned)wid * 1024u;
    const int aoff = lds_byte(wr * 64 + fr, fq * 8), boff = lds_byte(wc * 32 + fr, fq * 8);
#define PG8_SA(b, h) (((b) * 2 + (h)) * HTB)
#define PG8_SB(b, h) ((4 + (b) * 2 + (h)) * HTB)
#define PG8_STAGE(bufoff, gbase, voff) do { _Pragma("unroll") for (int _i = 0; _i < 2; ++_i) \
        __builtin_amdgcn_global_load_lds((const unsigned*)((const char*)(gbase) + (voff)[_i]), (LAS unsigned*)(lds + (bufoff) + ldsw + _i * 8192), 16, 0, 0); } while (0)
#define PG8_LDA(dst, b, h) do { _Pragma("unroll") for (int m = 0; m < 4; ++m) _Pragma("unroll") for (int k = 0; k < 2; ++k) dst[m][k] = *(const LAS bf16x8*)(lds + PG8_SA(b, h) + aoff + m * 2048 + k * 1024); } while (0)
#define PG8_LDB(dst, b, h) do { _Pragma("unroll") for (int n = 0; n < 2; ++n) _Pragma("unroll") for (int k = 0; k < 2; ++k) dst[n][k] = *(const LAS bf16x8*)(lds + PG8_SB(b, h) + boff + n * 2048 + k * 1024); } while (0)
#define PG8_MMA(ai, bj, At, Bt) do { __builtin_amdgcn_s_setprio(1); _Pragma("unroll") for (int m = 0; m < 4; ++m) _Pragma("unroll") for (int n = 0; n < 2; ++n) _Pragma("unroll") for (int k = 0; k < 2; ++k) \
        { if constexpr (Epi::I8) acc[ai][bj][m][n] = __builtin_bit_cast(f32x4, __builtin_amdgcn_mfma_i32_16x16x64_i8(__builtin_bit_cast(i32x4, Bt[n][k]), __builtin_bit_cast(i32x4, At[m][k]), __builtin_bit_cast(i32x4, acc[ai][bj][m][n]), 0, 0, 0)); \
          else acc[ai][bj][m][n] = __builtin_amdgcn_mfma_f32_16x16x32_bf16(Bt[n][k], At[m][k], acc[ai][bj][m][n], 0, 0, 0); } __builtin_amdgcn_s_setprio(0); } while (0)
#define PG8_WAIT_V(n) asm volatile("s_waitcnt vmcnt(" #n ")" ::: "memory")
#define PG8_WAIT_L(n) asm volatile("s_waitcnt lgkmcnt(" #n ")" ::: "memory")
#define PG8_BAR __builtin_amdgcn_s_barrier()
#define PG8_SCHED __builtin_amdgcn_sched_barrier(0)
    Unit cur, nxt; int ui = 0;
    if (!S.next(0, cur)) return;
    f32x4 acc[2][2][4][2];
#pragma unroll
    for (int a = 0; a < 2; ++a)
#pragma unroll
        for (int b = 0; b < 2; ++b)
#pragma unroll
            for (int m = 0; m < 4; ++m)
#pragma unroll
                for (int n = 0; n < 2; ++n) acc[a][b][m][n] = (f32x4){0.f, 0.f, 0.f, 0.f};
    bf16x8 At[4][2], B0[2][2], B1[2][2];
    const char* cA = (const char*)g.A + (size_t)cur.pm * tstep; const char* cB = (const char*)g.Bt + (size_t)cur.pn * tstep;
    PG8_STAGE(PG8_SB(0, 0), cB, voffB); PG8_STAGE(PG8_SA(0, 0), cA, voffA); PG8_STAGE(PG8_SB(0, 1), cB + hstep, voffB); PG8_STAGE(PG8_SA(0, 1), cA + hstep, voffA);
    if (wr == 1) PG8_BAR;
    PG8_WAIT_V(4); PG8_BAR;
    PG8_STAGE(PG8_SB(1, 0), cB + kstep, voffB); PG8_STAGE(PG8_SA(1, 0), cA + kstep, voffA); PG8_STAGE(PG8_SB(1, 1), cB + hstep + kstep, voffB);
    PG8_WAIT_V(6); PG8_BAR;
    for (;;) {
        const bool has_next = S.next(ui + 1, nxt);
        const char* nA = has_next ? (const char*)g.A + (size_t)nxt.pm * tstep : cA; const char* nB = has_next ? (const char*)g.Bt + (size_t)nxt.pn * tstep : cB;
        for (int t = 0; t < nt; t += 2) {
            const bool last = (t == nt - 2);
            const char* a1 = cA + (size_t)(t + 1) * kstep;
            const char* a2 = last ? nA : cA + (size_t)(t + 2) * kstep; const char* b2 = last ? nB : cB + (size_t)(t + 2) * kstep;
            const char* a3 = a2 + kstep; const char* b3 = b2 + kstep;
            PG8_LDB(B0, 0, 0); PG8_SCHED; PG8_LDA(At, 0, 0); PG8_STAGE(PG8_SA(1, 1), a1 + hstep, voffA);
            PG8_WAIT_L(8); PG8_BAR; PG8_WAIT_L(0); PG8_MMA(0, 0, At, B0); PG8_BAR; PG8_SCHED;
            PG8_LDB(B1, 0, 1); PG8_STAGE(PG8_SB(0, 0), b2, voffB);
            PG8_BAR; PG8_WAIT_L(0); PG8_MMA(0, 1, At, B1); PG8_BAR;
            PG8_LDA(At, 0, 1); PG8_STAGE(PG8_SA(0, 0), a2, voffA);
            PG8_BAR; PG8_WAIT_L(0); PG8_MMA(1, 0, At, B0); PG8_BAR; PG8_SCHED;
            PG8_STAGE(PG8_SB(0, 1), b2 + hstep, voffB);
            PG8_WAIT_V(6); PG8_BAR; PG8_MMA(1, 1, At, B1); PG8_BAR;
            PG8_LDB(B0, 1, 0); PG8_SCHED; PG8_LDA(At, 1, 0); PG8_STAGE(PG8_SA(0, 1), a2 + hstep, voffA);
            PG8_WAIT_L(8); PG8_BAR; PG8_WAIT_L(0); PG8_MMA(0, 0, At, B0); PG8_BAR; PG8_SCHED;
            PG8_LDB(B1, 1, 1); PG8_STAGE(PG8_SB(1, 0), b3, voffB);
            PG8_BAR; PG8_WAIT_L(0); PG8_MMA(0, 1, At, B1); PG8_BAR;
            PG8_LDA(At, 1, 1); PG8_STAGE(PG8_SA(1, 0), a3, voffA);
            PG8_BAR; PG8_WAIT_L(0); PG8_MMA(1, 0, At, B0); PG8_BAR; PG8_SCHED;
            PG8_STAGE(PG8_SB(1, 1), b3 + hstep, voffB);
            PG8_WAIT_V(6); PG8_BAR; PG8_MMA(1, 1, At, B1); PG8_BAR;
        }
        E(acc, cur, wr, wc, fr, fq);
        if (!has_next) break;
#pragma unroll
        for (int a = 0; a < 2; ++a)
#pragma unroll
            for (int b = 0; b < 2; ++b)
#pragma unroll
                for (int m = 0; m < 4; ++m)
#pragma unroll
                    for (int n = 0; n < 2; ++n) acc[a][b][m][n] = (f32x4){0.f, 0.f, 0.f, 0.f};
        cur = nxt; cA = nA; cB = nB; ++ui;
    }
    PG8_WAIT_V(0);
    if (wr == 0) PG8_BAR;
    PG8_BAR;
#undef PG8_SA
#undef PG8_SB
#undef PG8_STAGE
#undef PG8_LDA
#undef PG8_LDB
#undef PG8_MMA
#undef PG8_WAIT_V
#undef PG8_WAIT_L
#undef PG8_BAR
#undef PG8_SCHED
}
}

template <bool WITH_GR, bool WITH_I8 = false>
__device__ __forceinline__ void rmsnorm_rows(const float* src, const float* w, bf16_t* dst, float* gr_out, const float* wgrT, unsigned* q8 = nullptr, float* sx = nullptr) {
    const int lane = otid() & 63, wv = blockIdx.x * 8 + (otid() >> 6), nw = gridDim.x * 8;
    f32x4 wv4[4];
#pragma unroll
    for (int j = 0; j < 4; ++j) wv4[j] = *(const f32x4*)(w + j * 256 + lane * 4);
    for (int t = wv; t < T_; t += nw) {
        const float* row = src + (size_t)t * D_;
        f32x4 v[4]; float ss = 0.f;
#pragma unroll
        for (int j = 0; j < 4; ++j) { v[j] = *(const f32x4*)(row + j * 256 + lane * 4); ss += v[j][0] * v[j][0] + v[j][1] * v[j][1] + v[j][2] * v[j][2] + v[j][3] * v[j][3]; }
        ss = wave_sum(ss);
        const float rs = rsqrtf(ss * (1.0f / D_) + EPS_);
#pragma unroll
        for (int j = 0; j < 4; ++j) { v[j] = v[j] * rs * wv4[j];
            u32x2 o; o.x = pk2(v[j][0], v[j][1]); o.y = pk2(v[j][2], v[j][3]);
            *(u32x2*)(dst + (size_t)t * D_ + j * 256 + lane * 4) = o; }
        if (WITH_I8) {
            float am = 0.f;
#pragma unroll
            for (int j = 0; j < 4; ++j) am = fmaxf(am, fmaxf(fmaxf(fabsf(v[j][0]), fabsf(v[j][1])), fmaxf(fabsf(v[j][2]), fabsf(v[j][3]))));
            for (int o = 32; o > 0; o >>= 1) am = fmaxf(am, __shfl_xor(am, o));
            const float qs = am > 0.f ? 127.0f / am : 0.f;
#pragma unroll
            for (int j = 0; j < 4; ++j) { unsigned pkd = 0u;
#pragma unroll
                for (int i = 0; i < 4; ++i) { const int qi = (int)rintf(v[j][i] * qs); pkd |= ((unsigned)qi & 0xffu) << (8 * i); }
                q8[(size_t)t * 256 + j * 64 + lane] = pkd; }
            if (lane == 0) sx[t] = am * (1.0f / 127.0f);
        }
        if (WITH_GR) {
            float pr[16];
#pragma unroll
            for (int r = 0; r < 16; ++r) { float pp = 0.f;
#pragma unroll
                for (int j = 0; j < 4; ++j) { const f32x4 ww = *(const f32x4*)(wgrT + r * 1024 + j * 256 + lane * 4); pp += v[j][0] * ww[0] + v[j][1] * ww[1] + v[j][2] * ww[2] + v[j][3] * ww[3]; }
                pr[r] = pp; }
            const bool b5 = lane & 32, b4 = lane & 16, b3 = lane & 8, b2 = lane & 4;
            float a8[8], a4[4], a2[2], a1;
#pragma unroll
            for (int i = 0; i < 8; ++i) { const float a = b5 ? pr[i + 8] : pr[i], bb = b5 ? pr[i] : pr[i + 8]; a8[i] = a + __shfl_xor(bb, 32); }
#pragma unroll
            for (int i = 0; i < 4; ++i) { const float a = b4 ? a8[i + 4] : a8[i], bb = b4 ? a8[i] : a8[i + 4]; a4[i] = a + __shfl_xor(bb, 16); }
#pragma unroll
            for (int i = 0; i < 2; ++i) { const float a = b3 ? a4[i + 2] : a4[i], bb = b3 ? a4[i] : a4[i + 2]; a2[i] = a + __shfl_xor(bb, 8); }
            { const float a = b2 ? a2[1] : a2[0], bb = b2 ? a2[0] : a2[1]; a1 = a + __shfl_xor(bb, 4); }
            a1 += __shfl_xor(a1, 2); a1 += __shfl_xor(a1, 1);
            const int ridx = ((lane >> 5) & 1) * 8 + ((lane >> 4) & 1) * 4 + ((lane >> 3) & 1) * 2 + ((lane >> 2) & 1);
            if ((lane & 3) == 0) gr_out[(size_t)t * 16 + ridx] = a1;
        }
    }
}

__device__ void phase_prep(const Params& p, unsigned char* shm) {
    const int tid = otid();
    float* wgrT = (float*)shm;
    float* tile = (float*)(shm + 65536);
    for (int idx = tid; idx < 16384; idx += NTHR) { const int k = idx >> 4, r = idx & 15; wgrT[r * 1024 + k] = p.w_in[(size_t)k * WIN_LD + 1536 + r]; }
    __syncthreads();
    rmsnorm_rows<true>(p.x, p.norm1_w, (bf16_t*)(p.ws + WS_XN), (float*)(p.ws + WS_GR), wgrT);
    for (int tl = blockIdx.x; tl < 1536; tl += gridDim.x) {
        const float* src; bf16_t* dst; int ld, kt, ntile, scol;
        if (tl < 768) { src = p.w_in; dst = (bf16_t*)(p.ws + WS_WIN); ld = WIN_LD; kt = tl & 15; ntile = tl >> 4; scol = ntile * 64 + (ntile * 64 >= 1536 ? 16 : 0); }
        else if (tl < 1024) { const int q = tl - 768; src = p.w_out; dst = (bf16_t*)(p.ws + WS_WOUT); ld = 1024; kt = q & 15; ntile = q >> 4; scol = ntile * 64; }
        else { const int q = tl - 1024; src = p.w_query; dst = (bf16_t*)(p.ws + WS_WQ); ld = 2048; kt = q & 15; ntile = q >> 4; scol = ntile * 64; }
        const int k0 = kt * 64, n0 = ntile * 64;
#pragma unroll
        for (int i = 0; i < 8; ++i) { const int r = (tid >> 6) + 8 * i, c = tid & 63; tile[r * 65 + c] = src[(size_t)(k0 + r) * ld + scol + c]; }
        __syncthreads();
#pragma unroll
        for (int i = 0; i < 8; ++i) { const int nn = (tid >> 6) + 8 * i, kk = tid & 63; dst[(size_t)(n0 + nn) * 1024 + k0 + kk] = f2bf(tile[kk * 65 + nn]); }
        __syncthreads();
    }
    const size_t gtid = (size_t)blockIdx.x * NTHR + tid, gn = (size_t)gridDim.x * NTHR;
    for (int which = 0; which < 2; ++which) {
        const float* src = which ? p.peer_v : p.peer_u; unsigned char* dst = p.ws + (which ? WS_V : WS_U); const float sc = which ? 64.0f : 256.0f;
        for (size_t i = gtid; i < (size_t)16384 * 1024 / 16; i += gn) {
            u32x4 o;
#pragma unroll
            for (int q4 = 0; q4 < 4; ++q4) { const f32x4 a = *(const f32x4*)(src + i * 16 + q4 * 4);
                int w = __builtin_amdgcn_cvt_pk_fp8_f32(a[0] * sc, a[1] * sc, 0, false); w = __builtin_amdgcn_cvt_pk_fp8_f32(a[2] * sc, a[3] * sc, w, true); o[q4] = (unsigned)w; }
            *(u32x4*)(dst + i * 16) = o; }
    }
    { bf16_t* dst = (bf16_t*)(p.ws + WS_SK);
      for (size_t i = gtid; i < (size_t)262144 / 8; i += gn) {
          const f32x4 a = *(const f32x4*)(p.subkeys + i * 8), b = *(const f32x4*)(p.subkeys + i * 8 + 4);
          u32x4 o; o.x = pk2(a[0], a[1]); o.y = pk2(a[2], a[3]); o.z = pk2(b[0], b[1]); o.w = pk2(b[2], b[3]);
          *(u32x4*)(dst + i * 8) = o; } }
    { float* rt = (float*)(p.ws + WS_ROPE);
      for (size_t i = gtid; i < (size_t)4096 * 32; i += gn) {
          const int pos = (int)(i >> 5), k = (int)(i & 31);
          const float inv = (float)exp(-(double)k * (9.210340371976184 / 32.0));
          const float ang = (float)pos * inv;
          double rev = (double)ang * 0.15915494309189535; rev -= floor(rev);
          rt[i] = __builtin_amdgcn_cosf((float)rev); rt[131072 + i] = __builtin_amdgcn_sinf((float)rev); } }
}

__device__ void moba_prep_item(const Params& p, unsigned char* shm, int item) {
    const int tid = otid();
    const int h = item & 7, blk = (item >> 3) & 15, b = item >> 7, bh = b * 8 + h;
    bf16_t* proj = (bf16_t*)(p.ws + WS_PROJ);
    const float* rope = (const float*)(p.ws + WS_ROPE);
    float* kt = (float*)shm;
    unsigned* vt = (unsigned*)(shm + 66560);
    float* part = (float*)(shm + 66560 + 33792);
    const int tl = tid & 255, which = tid >> 8;
    const size_t trow = (size_t)(b * S_ + blk * 256 + tl);
    {
        bf16_t* ptr = proj + trow * NPROJ + (which ? C_MK : C_MQ) + h * 64;
        const float* nw = which ? p.mkw : p.mqw;
        float v[64]; float ss = 0.f;
#pragma unroll
        for (int i = 0; i < 8; ++i) { const u32x4 w = *(const u32x4*)(ptr + i * 8); unpack8(w, v + i * 8); }
#pragma unroll
        for (int i = 0; i < 64; ++i) ss += v[i] * v[i];
        const float rs = rsqrtf(ss * (1.0f / 64) + EPS_);
        const float qsc = which ? 1.0f : 0.18033688f;
        const int pos = blk * 256 + tl;
        const float* cp = rope + (size_t)pos * 32; const float* sp = cp + 131072;
#pragma unroll
        for (int i = 0; i < 32; i += 4) {
            const f32x4 c4 = *(const f32x4*)(cp + i), s4 = *(const f32x4*)(sp + i), w1 = *(const f32x4*)(nw + i), w2 = *(const f32x4*)(nw + 32 + i);
#pragma unroll
            for (int j = 0; j < 4; ++j) { const float x1 = v[i + j] * rs * w1[j] * qsc, x2 = v[32 + i + j] * rs * w2[j] * qsc;
                v[i + j] = x1 * c4[j] - x2 * s4[j]; v[32 + i + j] = x2 * c4[j] + x1 * s4[j]; }
        }
#pragma unroll
        for (int i = 0; i < 8; ++i) { u32x4 w; w.x = pk2(v[i * 8], v[i * 8 + 1]); w.y = pk2(v[i * 8 + 2], v[i * 8 + 3]); w.z = pk2(v[i * 8 + 4], v[i * 8 + 5]); w.w = pk2(v[i * 8 + 6], v[i * 8 + 7]); *(u32x4*)(ptr + i * 8) = w; }
        if (which) {
#pragma unroll
            for (int i = 0; i < 64; ++i) kt[tl * 65 + i] = v[i];
        }
    }
    {
        const bf16_t* ptr = proj + trow * NPROJ + C_MV + h * 64 + which * 32;
#pragma unroll
        for (int i = 0; i < 4; ++i) { const u32x4 w = *(const u32x4*)(ptr + i * 8); unsigned* d = vt + tl * 33 + which * 16 + i * 4; d[0] = w.x; d[1] = w.y; d[2] = w.z; d[3] = w.w; }
    }
    __syncthreads();
    {
        const int d = tid & 63, pr = tid >> 6; float s = 0.f;
#pragma unroll 8
        for (int r = 0; r < 32; ++r) s += kt[(pr * 32 + r) * 65 + d];
        part[pr * 64 + d] = s;
    }
    {
        const int d = tid >> 3, seg = tid & 7;
        bf16_t* dst = (bf16_t*)((unsigned char*)p.out + OUT_MVT) + ((size_t)bh * 64 + d) * S_ + blk * 256 + seg * 32;
        const bf16_t* vs = (const bf16_t*)vt;
        unsigned o[16];
#pragma unroll
        for (int i = 0; i < 16; ++i) { const unsigned lo = vs[(seg * 32 + 2 * i) * 66 + d], hi = vs[(seg * 32 + 2 * i + 1) * 66 + d]; o[i] = lo | (hi << 16); }
#pragma unroll
        for (int i = 0; i < 4; ++i) { u32x4 w; w.x = o[i * 4]; w.y = o[i * 4 + 1]; w.z = o[i * 4 + 2]; w.w = o[i * 4 + 3]; *(u32x4*)(dst + i * 8) = w; }
    }
    __syncthreads();
    if (tid < 64) { float s = 0.f;
#pragma unroll
        for (int i = 0; i < 8; ++i) s += part[i * 64 + tid];
        ((float*)((unsigned char*)p.out + OUT_KBAR))[((size_t)bh * 16 + blk) * 64 + tid] = s * (1.0f / 256); }
    __syncthreads();
}

__device__ void gla_local_item(const Params& p, unsigned char* shm, int item, float pgr0, float pgr1, float pwa0, float pwa1, float pba, u32x4 qraw, u32x4 kraw, u32x4 vraw0, u32x4 vraw1) {
    const int tid = otid(), lane = tid & 63, wv = tid >> 6, g = lane >> 4, lr = lane & 15;
    const int n = item & 63, h = (item >> 6) & 3, b = item >> 8, bh = b * 4 + h;
    const size_t t0 = (size_t)b * S_ + n * 64;
    bf16_t* proj = (bf16_t*)(p.ws + WS_PROJ);
    float* gr_s = (float*)shm;
    float* wa_s = (float*)(shm + 4096);
    float* ba_s = (float*)(shm + 8192);
    float* g_s = (float*)(shm + 8704);
    float* tot_s = (float*)(shm + 8704 + 16384);
    bf16_t* kstT = (bf16_t*)(shm + 27136);
    bf16_t* vT = (bf16_t*)(shm + 27136 + 9216);
    gr_s[tid] = pgr0; gr_s[tid + NTHR] = pgr1; wa_s[tid] = pwa0; wa_s[tid + NTHR] = pwa1;
    if (tid < 64) ba_s[tid] = pba;
    __syncthreads();
    { const int c = tid >> 3, dg = tid & 7;
#pragma unroll
      for (int dd = 0; dd < 8; ++dd) { const int d = dg * 8 + dd; float z = ba_s[d];
#pragma unroll
          for (int r = 0; r < 16; ++r) z += gr_s[c * 16 + r] * wa_s[r * 64 + d];
          const float ls = fminf(z, 0.f) - __logf(1.0f + __expf(-fabsf(z)));
          g_s[c * 64 + d] = ls * (1.0f / 16.0f); } }
    __syncthreads();
    { const int d = tid & 63, seg = tid >> 6; float run = 0.f;
#pragma unroll
      for (int i = 0; i < 8; ++i) { run += g_s[(seg * 8 + i) * 64 + d]; g_s[(seg * 8 + i) * 64 + d] = run; }
      tot_s[seg * 64 + d] = run; }
    __syncthreads();
    { const int d = tid & 63, seg = tid >> 6; float off = 0.f;
      for (int s = 0; s < seg; ++s) off += tot_s[s * 64 + d];
#pragma unroll
      for (int i = 0; i < 8; ++i) g_s[(seg * 8 + i) * 64 + d] += off; }
    __syncthreads();
    { const int c = tid >> 3, dg = tid & 7;
      bf16_t* qp = proj + (t0 + c) * NPROJ + C_GQ + h * 64 + dg * 8; bf16_t* kp = proj + (t0 + c) * NPROJ + C_GK + h * 64 + dg * 8;
      float q[8], k[8]; unpack8(qraw, q); unpack8(kraw, k);
      float qd[8], ki[8];
#pragma unroll
      for (int dd = 0; dd < 8; ++dd) { const int d = dg * 8 + dd; const float bb = g_s[c * 64 + d], bl = g_s[63 * 64 + d];
          qd[dd] = q[dd] * __expf(bb) * 0.125f; ki[dd] = k[dd] * __expf(-bb); kstT[d * 72 + c] = f2bf(k[dd] * __expf(bl - bb)); }
      u32x4 w; w.x = pk2(qd[0], qd[1]); w.y = pk2(qd[2], qd[3]); w.z = pk2(qd[4], qd[5]); w.w = pk2(qd[6], qd[7]); *(u32x4*)qp = w;
      w.x = pk2(ki[0], ki[1]); w.y = pk2(ki[2], ki[3]); w.z = pk2(ki[4], ki[5]); w.w = pk2(ki[6], ki[7]); *(u32x4*)kp = w;
#pragma unroll
      for (int i = 0; i < 2; ++i) { const u32x4 vv = i ? vraw1 : vraw0; const int e0 = dg * 16 + i * 8;
          vT[(e0 + 0) * 72 + c] = (bf16_t)(vv.x & 0xffff); vT[(e0 + 1) * 72 + c] = (bf16_t)(vv.x >> 16);
          vT[(e0 + 2) * 72 + c] = (bf16_t)(vv.y & 0xffff); vT[(e0 + 3) * 72 + c] = (bf16_t)(vv.y >> 16);
          vT[(e0 + 4) * 72 + c] = (bf16_t)(vv.z & 0xffff); vT[(e0 + 5) * 72 + c] = (bf16_t)(vv.z >> 16);
          vT[(e0 + 6) * 72 + c] = (bf16_t)(vv.w & 0xffff); vT[(e0 + 7) * 72 + c] = (bf16_t)(vv.w >> 16); }
      if (tid < 64) ((float*)(p.ws + WS_DECAY))[((size_t)bh * 64 + n) * 64 + tid] = expf(g_s[63 * 64 + tid]);
    }
    __syncthreads();
    {
      const int e = tid >> 2, cs = tid & 3;
      bf16_t* dst = (bf16_t*)((unsigned char*)p.out + OUT_GVT) + ((size_t)bh * 128 + e) * S_ + n * 64 + cs * 16;
      *(u32x4*)dst = *(const u32x4*)(vT + e * 72 + cs * 16); *(u32x4*)(dst + 8) = *(const u32x4*)(vT + e * 72 + cs * 16 + 8); }
    {
      f32x4 acc[4];
#pragma unroll
      for (int dt = 0; dt < 4; ++dt) acc[dt] = (f32x4){0.f, 0.f, 0.f, 0.f};
#pragma unroll
      for (int ks = 0; ks < 2; ++ks) { const bf16x8 a = *(const bf16x8*)(vT + (wv * 16 + lr) * 72 + ks * 32 + g * 8);
#pragma unroll
          for (int dt = 0; dt < 4; ++dt) { const bf16x8 bb = *(const bf16x8*)(kstT + (dt * 16 + lr) * 72 + ks * 32 + g * 8); acc[dt] = MFMA32(a, bb, acc[dt]); } }
      float* st = (float*)(p.ws + WS_XN) + ((size_t)bh * 64 + n) * 8192;
#pragma unroll
      for (int dt = 0; dt < 4; ++dt)
#pragma unroll
          for (int j = 0; j < 4; ++j) st[(wv * 16 + g * 4 + j) * 64 + dt * 16 + lr] = acc[dt][j]; }
    __syncthreads();
}

__device__ void quant_wq(const Params& p) {
    const int lane = otid() & 63, wg = blockIdx.x * 8 + (otid() >> 6), nw = gridDim.x * 8;
    const bf16_t* wq = (const bf16_t*)(p.ws + WS_WQ); unsigned char* w8 = p.ws + WS_WQ8; float* sw = (float*)(p.ws + WS_SW);
    for (int n = wg; n < 2048; n += nw) {
        float f[16]; const u32x4* rp = (const u32x4*)(wq + (size_t)n * 1024 + lane * 16); unpack8(rp[0], f); unpack8(rp[1], f + 8);
        float am = 0.f;
#pragma unroll
        for (int i = 0; i < 16; ++i) am = fmaxf(am, fabsf(f[i]));
        for (int o = 32; o > 0; o >>= 1) am = fmaxf(am, __shfl_xor(am, o));
        const float qs = am > 0.f ? 127.0f / am : 0.f;
        u32x4 o4;
#pragma unroll
        for (int q = 0; q < 4; ++q) { unsigned pkd = 0u;
#pragma unroll
            for (int i = 0; i < 4; ++i) { const int qi = (int)rintf(f[q * 4 + i] * qs); pkd |= ((unsigned)qi & 0xffu) << (8 * i); }
            o4[q] = pkd; }
        *(u32x4*)(w8 + (size_t)n * 1024 + lane * 16) = o4;
        if (lane == 0) sw[n] = am * (1.0f / 127.0f);
    }
}
__device__ void phase_mixprep(const Params& p, unsigned char* shm) {
    quant_wq(p);
    float pgr0 = 0.f, pgr1 = 0.f, pwa0 = 0.f, pwa1 = 0.f, pba = 0.f; u32x4 pq = {0u, 0u, 0u, 0u}, pk = pq, pv0 = pq, pv1 = pq;
    const int tid = otid();
#define GLA_ISSUE(item_) do { const int n_ = (item_) & 63, h_ = ((item_) >> 6) & 3, b_ = (item_) >> 8; const size_t t0_ = (size_t)b_ * S_ + n_ * 64; \
        const float* gr_ = (const float*)(p.ws + WS_GR); const bf16_t* pj_ = (const bf16_t*)(p.ws + WS_PROJ) + (t0_ + (tid >> 3)) * NPROJ; \
        pgr0 = gr_[t0_ * 16 + tid]; pgr1 = gr_[t0_ * 16 + NTHR + tid]; \
        pwa0 = p.w_alpha[(size_t)(tid >> 6) * 256 + h_ * 64 + (tid & 63)]; pwa1 = p.w_alpha[(size_t)((tid + NTHR) >> 6) * 256 + h_ * 64 + (tid & 63)]; pba = p.b_alpha[h_ * 64 + (tid & 63)]; \
        pq = *(const u32x4*)(pj_ + C_GQ + h_ * 64 + (tid & 7) * 8); pk = *(const u32x4*)(pj_ + C_GK + h_ * 64 + (tid & 7) * 8); \
        pv0 = *(const u32x4*)(pj_ + C_GV + h_ * 128 + (tid & 7) * 16); pv1 = *(const u32x4*)(pj_ + C_GV + h_ * 128 + (tid & 7) * 16 + 8); } while (0)
    int it = blockIdx.x;
    for (; it < 512; it += gridDim.x) moba_prep_item(p, shm, it);
    if (it < 1536) GLA_ISSUE(it - 512);
    for (; it < 1536; it += gridDim.x) {
        const float c0 = pgr0, c1 = pgr1, c2 = pwa0, c3 = pwa1, c4 = pba; const u32x4 cq = pq, ck = pk, cv0 = pv0, cv1 = pv1;
        if (it + (int)gridDim.x < 1536) GLA_ISSUE(it + (int)gridDim.x - 512);
        gla_local_item(p, shm, it - 512, c0, c1, c2, c3, c4, cq, ck, cv0, cv1);
    }
#undef GLA_ISSUE
}

__device__ void gla_scan(const Params& p) {
    const int gid = blockIdx.x * NTHR + otid(), gn = gridDim.x * NTHR;
    float* st = (float*)(p.ws + WS_XN); const float* dec = (const float*)(p.ws + WS_DECAY);
    for (int e = gid; e < 16 * 8192; e += gn) {
        const int bh = e >> 13, el = e & 8191, d = el & 63; float s = 0.f;
        for (int n0 = 0; n0 < 64; n0 += 8) { float u[8], dc[8];
#pragma unroll
            for (int k = 0; k < 8; ++k) { u[k] = st[((size_t)bh * 64 + n0 + k) * 8192 + el]; dc[k] = dec[((size_t)bh * 64 + n0 + k) * 64 + d]; }
#pragma unroll
            for (int k = 0; k < 8; ++k) { st[((size_t)bh * 64 + n0 + k) * 8192 + el] = s; s = dc[k] * s + u[k]; } }
    }
}

__device__ void moba_attn_item(const Params& p, unsigned char* shm, int bh, int blk) {
    const int tid = otid(), lane = tid & 63, wv = tid >> 6, g = lane >> 4, lr = lane & 15;
    const int b = bh >> 3, h = bh & 7, q0 = blk * 256;
    const bf16_t* proj = (const bf16_t*)(p.ws + WS_PROJ);
    const bf16_t* mvT = (const bf16_t*)((unsigned char*)p.out + OUT_MVT) + (size_t)bh * 64 * S_;
    const float* kbar = (const float*)((unsigned char*)p.out + OUT_KBAR) + (size_t)bh * 16 * 64;
    bf16_t* Ks = (bf16_t*)shm;
    bf16_t* VTs = (bf16_t*)(shm + 36864);
    unsigned* sel_s = (unsigned*)(shm + 36864 + 34816);
    if (tid == 0) sel_s[256] = 0u;
    if (tid < 64) {
        float aq = fabsf(p.mqw[tid]), ak = fabsf(p.mkw[tid]);
        for (int o = 32; o > 0; o >>= 1) { aq = fmaxf(aq, __shfl_xor(aq, o)); ak = fmaxf(ak, __shfl_xor(ak, o)); }
        if (tid == 0) ((float*)sel_s)[257] = 8.2f * aq * ak * 1.44269504f;
    }
    __syncthreads();
    if (tid < 256) {
        unsigned mask;
        if (blk <= 3) mask = (1u << blk) - 1u;
        else {
            float q[64]; const bf16_t* qp = proj + ((size_t)b * S_ + q0 + tid) * NPROJ + C_MQ + h * 64;
#pragma unroll
            for (int i = 0; i < 8; ++i) unpack8(*(const u32x4*)(qp + i * 8), q + i * 8);
            float v0 = -INFINITY, v1 = -INFINITY, v2 = -INFINITY; int i0 = 0, i1 = 0, i2 = 0;
            for (int j = 0; j < blk; ++j) { float s = 0.f;
#pragma unroll
                for (int i = 0; i < 64; i += 4) { const f32x4 kk = *(const f32x4*)(kbar + j * 64 + i); s += q[i] * kk[0] + q[i + 1] * kk[1] + q[i + 2] * kk[2] + q[i + 3] * kk[3]; }
                if (s > v0) { v2 = v1; i2 = i1; v1 = v0; i1 = i0; v0 = s; i0 = j; } else if (s > v1) { v2 = v1; i2 = i1; v1 = s; i1 = j; } else if (s > v2) { v2 = s; i2 = j; } }
            mask = (1u << i0) | (1u << i1) | (1u << i2);
        }
        sel_s[tid] = mask; atomicOr(&sel_s[256], mask);
    }
    __syncthreads();
    const unsigned umask = sel_s[256]; const float mbound = ((const float*)sel_s)[257];
    unsigned mysel[2]; int qabs[2]; bf16x8 qb[2][2]; f32x4 acc[2][4], lacc[2];
    const bf16x8 ones = {(short)0x3F80, (short)0x3F80, (short)0x3F80, (short)0x3F80, (short)0x3F80, (short)0x3F80, (short)0x3F80, (short)0x3F80};
#pragma unroll
    for (int u = 0; u < 2; ++u) {
        mysel[u] = sel_s[wv * 32 + u * 16 + lr]; qabs[u] = q0 + wv * 32 + u * 16 + lr;
        const bf16_t* qp = proj + ((size_t)b * S_ + qabs[u]) * NPROJ + C_MQ + h * 64 + g * 8; qb[u][0] = *(const bf16x8*)qp; qb[u][1] = *(const bf16x8*)(qp + 32);
#pragma unroll
        for (int dt = 0; dt < 4; ++dt) acc[u][dt] = (f32x4){0.f, 0.f, 0.f, 0.f};
        lacc[u] = (f32x4){0.f, 0.f, 0.f, 0.f}; }
    const int bp32 = (lane ^ 32) * 4;
    u32x4 kreg[4], vreg[4];
    int j = 0; while (j < blk && !((umask >> j) & 1u)) ++j;
#define MOBA_LOAD(jj) do { _Pragma("unroll") for (int i = 0; i < 4; ++i) { const int c = tid + NTHR * i; \
            kreg[i] = *(const u32x4*)(proj + ((size_t)b * S_ + (jj) * 256 + (c >> 3)) * NPROJ + C_MK + h * 64 + (c & 7) * 8); \
            vreg[i] = *(const u32x4*)(mvT + (size_t)(c >> 5) * S_ + (jj) * 256 + (c & 31) * 8); } } while (0)
#define MOBA_STORE() do { _Pragma("unroll") for (int i = 0; i < 4; ++i) { const int c = tid + NTHR * i; \
            *(u32x4*)(Ks + (c >> 3) * 72 + (c & 7) * 8) = kreg[i]; *(u32x4*)(VTs + (c >> 5) * 272 + (c & 31) * 8) = vreg[i]; } } while (0)
    MOBA_LOAD(j); MOBA_STORE();
    __syncthreads();
    while (j <= blk) {
        int jn = j + 1; while (jn < blk && !((umask >> jn) & 1u)) ++jn;
        if (jn <= blk) MOBA_LOAD(jn);
        const bool own = (j == blk);
        const bool on0 = own || ((mysel[0] >> j) & 1u), on1 = own || ((mysel[1] >> j) & 1u);
        if (__any(on0 || on1)) {
            const float bias[2] = {on0 ? -mbound : -INFINITY, on1 ? -mbound : -INFINITY};
            const int kend = own ? wv + 1 : 8;
            for (int kk = 0; kk < kend; ++kk) {
                bf16x8 kf[2][2];
#pragma unroll
                for (int hf = 0; hf < 2; ++hf) { const bf16_t* kp = Ks + (kk * 32 + hf * 16 + lr) * 72 + g * 8; kf[hf][0] = *(const bf16x8*)kp; kf[hf][1] = *(const bf16x8*)(kp + 32); }
                bf16x8 vf[4];
#pragma unroll
                for (int dt = 0; dt < 4; ++dt) { const bf16_t* vp = VTs + (dt * 16 + lr) * 272 + kk * 32 + g * 4; vf[dt] = as_bf16x8_2(*(const u32x2*)vp, *(const u32x2*)(vp + 16)); }
                const bool diag = own && (kk == wv);
                bf16x8 pb[2];
#pragma unroll
                for (int u = 0; u < 2; ++u) {
                    f32x4 st[2];
#pragma unroll
                    for (int hf = 0; hf < 2; ++hf) { st[hf] = MFMA32(kf[hf][0], qb[u][0], ((f32x4){bias[u], bias[u], bias[u], bias[u]})); st[hf] = MFMA32(kf[hf][1], qb[u][1], st[hf]); }
                    float sv[8];
#pragma unroll
                    for (int hf = 0; hf < 2; ++hf)
#pragma unroll
                        for (int jj = 0; jj < 4; ++jj) sv[hf * 4 + jj] = st[hf][jj];
                    if (diag) {
#pragma unroll
                        for (int hf = 0; hf < 2; ++hf)
#pragma unroll
                            for (int jj = 0; jj < 4; ++jj) if (j * 256 + kk * 32 + hf * 16 + g * 4 + jj > qabs[u]) sv[hf * 4 + jj] = -INFINITY;
                    }
                    float pv[8];
#pragma unroll
                    for (int i = 0; i < 8; ++i) pv[i] = __builtin_amdgcn_exp2f(sv[i]);
                    u32x4 pw; pw.x = pk2(pv[0], pv[1]); pw.y = pk2(pv[2], pv[3]); pw.z = pk2(pv[4], pv[5]); pw.w = pk2(pv[6], pv[7]);
                    pb[u] = as_bf16x8(pw);
                }
#pragma unroll
                for (int u = 0; u < 2; ++u) {
#pragma unroll
                    for (int dt = 0; dt < 4; ++dt) acc[u][dt] = MFMA32(vf[dt], pb[u], acc[u][dt]);
                    lacc[u] = MFMA32(ones, pb[u], lacc[u]); }
            }
        }
        __syncthreads();
        if (jn <= blk) MOBA_STORE();
        __syncthreads();
        j = jn;
    }
#undef MOBA_LOAD
#undef MOBA_STORE
#pragma unroll
    for (int u = 0; u < 2; ++u) {
        const float il = 1.0f / lacc[u][0];
        bf16_t* mixed = (bf16_t*)(p.ws + WS_MIXED) + ((size_t)b * S_ + qabs[u]) * 1024 + 512 + h * 64;
#pragma unroll
        for (int dt = 0; dt < 4; ++dt) { const f32x4 sc = *(const f32x4*)(p.mix_scale + 512 + h * 64 + dt * 16 + g * 4);
            u32x2 o; o.x = pk2(acc[u][dt][0] * il * sc[0], acc[u][dt][1] * il * sc[1]); o.y = pk2(acc[u][dt][2] * il * sc[2], acc[u][dt][3] * il * sc[3]);
            *(u32x2*)(mixed + dt * 16 + g * 4) = o; }
    }
}

__device__ void phase_moba(const Params& p, unsigned char* shm) {
    for (int it = blockIdx.x; it < 512; it += gridDim.x) {
        const int j = it & 255, r = it >> 8, a = j >> 5, bh = j & 31;
        moba_attn_item(p, shm, bh, r ? 15 - a : a);
    }
}
__device__ void phase_scan_moba(const Params& p, unsigned char* shm) { gla_scan(p); phase_moba(p, shm); }

__device__ void gla_out_task(const Params& p, int item, int it) {
    const int lane = otid() & 63, g = lane >> 4, lr = lane & 15;
    const int n = item & 63, h = (item >> 6) & 3, b = item >> 8, bh = b * 4 + h;
    const size_t t0 = (size_t)b * S_ + n * 64; const int i0 = it * 16;
    const bf16_t* proj = (const bf16_t*)(p.ws + WS_PROJ);
    const bf16_t* gvT = (const bf16_t*)((unsigned char*)p.out + OUT_GVT) + (size_t)bh * 128 * S_ + n * 64;
    const float* st = (const float*)(p.ws + WS_XN) + ((size_t)bh * 64 + n) * 8192;
    bf16x8 qd[2];
    { const bf16_t* qp = proj + (t0 + i0 + lr) * NPROJ + C_GQ + h * 64 + g * 8; qd[0] = *(const bf16x8*)qp; qd[1] = *(const bf16x8*)(qp + 32); }
    f32x4 acc[8];
#pragma unroll
    for (int et = 0; et < 8; ++et) acc[et] = (f32x4){0.f, 0.f, 0.f, 0.f};
#pragma unroll
    for (int et = 0; et < 8; ++et)
#pragma unroll
        for (int ks = 0; ks < 2; ++ks) { const float* sp = st + (et * 16 + lr) * 64 + ks * 32 + g * 8; const f32x4 a = *(const f32x4*)sp, c = *(const f32x4*)(sp + 4);
            u32x4 w; w.x = pk2(a[0], a[1]); w.y = pk2(a[2], a[3]); w.z = pk2(c[0], c[1]); w.w = pk2(c[2], c[3]);
            acc[et] = MFMA32(as_bf16x8(w), qd[ks], acc[et]); }
    for (int jt = 0; jt <= it; ++jt) {
        const int j0 = jt * 16;
        const bf16_t* kp = proj + (t0 + j0 + lr) * NPROJ + C_GK + h * 64 + g * 8;
        f32x4 at = MFMA32(*(const bf16x8*)kp, qd[0], ((f32x4){0.f, 0.f, 0.f, 0.f})); at = MFMA32(*(const bf16x8*)(kp + 32), qd[1], at);
#pragma unroll
        for (int jj = 0; jj < 4; ++jj) if (j0 + g * 4 + jj > i0 + lr) at[jj] = 0.f;
        u32x2 aw; aw.x = pk2(at[0], at[1]); aw.y = pk2(at[2], at[3]);
        const bf16x4 ab = as_bf16x4(aw);
#pragma unroll
        for (int et = 0; et < 8; ++et) { const u32x2 vv = *(const u32x2*)(gvT + (size_t)(et * 16 + lr) * S_ + j0 + g * 4); acc[et] = MFMA16(as_bf16x4(vv), ab, acc[et]); }
    }
    float ss = 0.f;
#pragma unroll
    for (int et = 0; et < 8; ++et) ss += acc[et][0] * acc[et][0] + acc[et][1] * acc[et][1] + acc[et][2] * acc[et][2] + acc[et][3] * acc[et][3];
    ss += __shfl_xor(ss, 16); ss += __shfl_xor(ss, 32);
    const float rs = rsqrtf(ss * (1.0f / 128) + EPS_);
    const size_t t = t0 + i0 + lr;
    bf16_t* mixed = (bf16_t*)(p.ws + WS_MIXED) + t * 1024 + h * 128;
#pragma unroll
    for (int et = 0; et < 8; ++et) { const int e0 = et * 16 + g * 4;
        const f32x4 w = *(const f32x4*)(p.gla_onw + e0), sc = *(const f32x4*)(p.mix_scale + h * 128 + e0);
        const u32x2 gw = *(const u32x2*)(proj + t * NPROJ + C_GG + h * 128 + e0);
        const float gt[4] = {lo_f(gw.x), hi_f(gw.x), lo_f(gw.y), hi_f(gw.y)}; float y[4];
#pragma unroll
        for (int j = 0; j < 4; ++j) { const float sl = gt[j] / (1.0f + __expf(-gt[j])); y[j] = acc[et][j] * rs * w[j] * sl * sc[j]; }
        u32x2 o; o.x = pk2(y[0], y[1]); o.y = pk2(y[2], y[3]); *(u32x2*)(mixed + e0) = o; }
}
__device__ void phase_gla_out(const Params& p) {
    const int wg = blockIdx.x * 8 + (otid() >> 6), nw = gridDim.x * 8; int rnd = 0;
    for (int tk = wg; tk < 4096; tk += nw, ++rnd) { const int it = (rnd & 1) ? 3 - (tk & 3) : (tk & 3); gla_out_task(p, tk >> 2, it); }
}

__constant__ unsigned char c_stair[52] = {
    0x00, 0x01, 0x02, 0x03, 0x04, 0x05, 0x06, 0x07, 0x08, 0x09, 0x0a, 0x0b, 0x0c, 0x0d, 0x0e, 0x0f,
    0x10, 0x11, 0x12, 0x13, 0x14, 0x15, 0x16, 0x17, 0x20, 0x21, 0x22, 0x23, 0x24, 0x30, 0x31, 0x32, 0x33,
    0x40, 0x41, 0x42, 0x50, 0x51, 0x60, 0x61, 0x70, 0x71, 0x80, 0x90, 0xa0, 0xb0, 0xc0, 0xd0, 0xe0, 0xf0, 0x00, 0x00};

__device__ void peer_topk_task(const Params& p, unsigned char* shm, int grp, int h) {
    const int lane = otid() & 63, wv = otid() >> 6, g = lane >> 4, lr = lane & 15;
    const bf16_t* sk_s = (const bf16_t*)shm;
    float* sv_s = (float*)(shm + 69632 + wv * 4096);
    int* si_s = (int*)(shm + 69632 + wv * 4096 + 2048);
    const unsigned char* stair_s = (const unsigned char*)(shm + 69632 + 8 * 4096);
    const bf16_t* q = (const bf16_t*)(p.ws + WS_PROJ) + ((size_t)grp * 16 + lr) * 2048 + h * 256;
    const int bp32 = (lane ^ 32) * 4;
#pragma unroll 1
    for (int pp = 0; pp < 2; ++pp) {
        bf16x8 qf[4];
#pragma unroll
        for (int ks = 0; ks < 4; ++ks) qf[ks] = *(const bf16x8*)(q + pp * 128 + ks * 32 + g * 8);
        unsigned pk[32];
#pragma unroll
        for (int kt = 0; kt < 8; ++kt) { f32x4 a = (f32x4){0.f, 0.f, 0.f, 0.f};
#pragma unroll
            for (int ks = 0; ks < 4; ++ks) a = MFMA32(*(const bf16x8*)(sk_s + (pp * 128 + kt * 16 + lr) * 136 + ks * 32 + g * 8), qf[ks], a);
#pragma unroll
            for (int jj = 0; jj < 4; ++jj) pk[kt * 4 + jj] = (ordf(a[jj]) & ~127u) | (unsigned)(127 - (kt * 16 + g * 4 + jj)); }
        unsigned thr = 0u;
#pragma unroll 1
        for (int r = 0; r < 16; ++r) {
            unsigned dm = pk[0] - thr;
#pragma unroll
            for (int i = 1; i < 32; ++i) dm = max(dm, pk[i] - thr);
            dm = max(dm, (unsigned)__builtin_amdgcn_ds_swizzle((int)dm, 0x401F)); dm = max(dm, (unsigned)__builtin_amdgcn_ds_bpermute(bp32, (int)dm));
            const unsigned mm = dm + thr; thr = mm;
            if (g == 0) { sv_s[(pp * 16 + r) * 16 + lr] = unordf(mm & ~127u); si_s[(pp * 16 + r) * 16 + lr] = 127 - (int)(mm & 127u); }
        }
    }
    __builtin_amdgcn_wave_barrier();
    unsigned cp[13];
#pragma unroll
    for (int mi = 0; mi < 13; ++mi) { const int c = g + 4 * mi; const int ij = stair_s[c];
        const float val = sv_s[(ij >> 4) * 16 + lr] + sv_s[(16 + (ij & 15)) * 16 + lr];
        cp[mi] = (c < 50) ? ((ordf(val) & ~63u) | (unsigned)(63 - c)) : 0u; }
    float ts[16]; int ex[16];
    unsigned cthr = 0u;
#pragma unroll
    for (int r = 0; r < 16; ++r) {
        unsigned dm = cp[0] - cthr;
#pragma unroll
        for (int i = 1; i < 13; ++i) dm = max(dm, cp[i] - cthr);
        dm = max(dm, (unsigned)__builtin_amdgcn_ds_swizzle((int)dm, 0x401F)); dm = max(dm, (unsigned)__builtin_amdgcn_ds_bpermute(bp32, (int)dm));
        const unsigned mm = dm + cthr; cthr = mm;
        const int c = 63 - (int)(mm & 63u); const int ij = stair_s[c];
        ts[r] = sv_s[(ij >> 4) * 16 + lr] + sv_s[(16 + (ij & 15)) * 16 + lr];
        ex[r] = si_s[(ij >> 4) * 16 + lr] * 128 + si_s[(16 + (ij & 15)) * 16 + lr];
    }
    float mx = ts[0];
#pragma unroll
    for (int r = 1; r < 16; ++r) mx = fmaxf(mx, ts[r]);
    float sum = 0.f;
#pragma unroll
    for (int r = 0; r < 16; ++r) { ts[r] = __expf(ts[r] - mx); sum += ts[r]; }
    const float inv = 1.0f / sum;
    if (g == 0) {
        int* eo = (int*)(p.ws + WS_MIXED) + ((size_t)grp * 16 + lr) * 128 + h * 16;
        float* go = (float*)(p.ws + WS_MIXED + 8 * MB) + ((size_t)grp * 16 + lr) * 128 + h * 16;
#pragma unroll
        for (int r = 0; r < 16; r += 4) { *(int4*)(eo + r) = make_int4(ex[r], ex[r + 1], ex[r + 2], ex[r + 3]);
            *(f32x4*)(go + r) = (f32x4){ts[r] * inv, ts[r + 1] * inv, ts[r + 2] * inv, ts[r + 3] * inv}; }
    }
    __builtin_amdgcn_wave_barrier();
}
__device__ void phase_peer_topk(const Params& p, unsigned char* shm) {
    const int tid = otid(), wv = tid >> 6, h = blockIdx.x & 7, slot = blockIdx.x >> 3, nslot = gridDim.x >> 3;
    if (slot >= nslot) return;
    { const bf16_t* sk = (const bf16_t*)(p.ws + WS_SK) + (size_t)h * 2 * 128 * 128; bf16_t* sk_s = (bf16_t*)shm;
      for (int c = tid; c < 4096; c += NTHR) { const int row = c >> 4, part = c & 15; *(u32x4*)(sk_s + row * 136 + part * 8) = *(const u32x4*)(sk + (size_t)row * 128 + part * 8); }
      if (tid < 52) shm[69632 + 8 * 4096 + tid] = c_stair[tid]; }
    __syncthreads();
    for (int grp = slot * 8 + wv; grp < 1024; grp += nslot * 8) peer_topk_task(p, shm, grp, h);
}

__device__ __forceinline__ void pg_load(const unsigned char* U, const unsigned char* V, int esel, int lbase, int lane, u32x4 (&ur)[4], u32x4 (&vr)[4]) {
#pragma unroll
    for (int k = 0; k < 4; ++k) { const int id = __builtin_amdgcn_readlane(esel, lbase + k); ur[k] = *(const u32x4*)(U + (size_t)id * 1024 + lane * 16); }
#pragma unroll
    for (int k = 0; k < 4; ++k) { const int id = __builtin_amdgcn_readlane(esel, lbase + k); vr[k] = *(const u32x4*)(V + (size_t)id * 1024 + lane * 16); }
}
typedef float f32x2 __attribute__((ext_vector_type(2)));
__device__ __forceinline__ void fp8x16_pk(const u32x4 w, f32x2* f) {
#pragma unroll
    for (int q = 0; q < 4; ++q) { f[q * 2] = __builtin_amdgcn_cvt_pk_f32_fp8((int)w[q], false); f[q * 2 + 1] = __builtin_amdgcn_cvt_pk_f32_fp8((int)w[q], true); }
}
__device__ __forceinline__ void fp8x16(const u32x4 w, float* f) {
#pragma unroll
    for (int q = 0; q < 4; ++q) { const auto lo = __builtin_amdgcn_cvt_pk_f32_fp8((int)w[q], false); const auto hi = __builtin_amdgcn_cvt_pk_f32_fp8((int)w[q], true);
        f[q * 4] = lo[0]; f[q * 4 + 1] = lo[1]; f[q * 4 + 2] = hi[0]; f[q * 4 + 3] = hi[1]; }
}
__device__ __forceinline__ void pg_comp(const u32x4 (&ur)[4], const u32x4 (&vr)[4], const float* xf, float* acc, float gsel, int lbase, int lane) {
    const bool b5 = lane & 32, b4 = lane & 16;
    const int kmine = ((lane >> 5) & 1) * 2 + ((lane >> 4) & 1);
    float d[4];
#pragma unroll
    for (int k = 0; k < 4; ++k) { float uf[16]; fp8x16(ur[k], uf); float s = 0.f;
#pragma unroll
        for (int i = 0; i < 16; ++i) s += uf[i] * xf[i];
        d[k] = s; }
    float r2[2], r1;
#pragma unroll
    for (int i = 0; i < 2; ++i) { const float a = b5 ? d[i + 2] : d[i], bb = b5 ? d[i] : d[i + 2]; r2[i] = a + __shfl_xor(bb, 32); }
    { const float a = b4 ? r2[1] : r2[0], bb = b4 ? r2[0] : r2[1]; r1 = a + __shfl_xor(bb, 16); }
    r1 += __shfl_xor(r1, 8); r1 += __shfl_xor(r1, 4); r1 += __shfl_xor(r1, 2); r1 += __shfl_xor(r1, 1);
    r1 *= (1.0f / 256.0f);
    const float gt = __shfl(gsel, lbase + kmine);
    const float wgt = gt * gelu_erf(r1) * (1.0f / 64.0f);
#pragma unroll
    for (int k = 0; k < 4; ++k) { const float wk = __int_as_float(__builtin_amdgcn_readlane(__float_as_int(wgt), ((k >> 1) & 1) * 32 + (k & 1) * 16));
        float vf[16]; fp8x16(vr[k], vf);
#pragma unroll
        for (int i = 0; i < 16; ++i) acc[i] += wk * vf[i]; }
}
__device__ void phase_peer_gather(const Params& p, float* dst) {
    const int lane = otid() & 63, wg = blockIdx.x * 8 + (otid() >> 6), nw = gridDim.x * 8;
    const unsigned char* U = p.ws + WS_U; const unsigned char* V = p.ws + WS_V;
    const bf16_t* xn = (const bf16_t*)(p.ws + WS_XN);
    const int* eid = (const int*)(p.ws + WS_MIXED); const float* gate = (const float*)(p.ws + WS_MIXED + 8 * MB);
    for (int tok = wg; tok < T_; tok += nw) {
        float xf[16];
        { const u32x4* xp = (const u32x4*)(xn + (size_t)tok * 1024 + lane * 16); unpack8(xp[0], xf); unpack8(xp[1], xf + 8); }
        const int e0 = eid[(size_t)tok * 128 + lane], e1 = eid[(size_t)tok * 128 + 64 + lane];
        const float g0 = gate[(size_t)tok * 128 + lane], g1 = gate[(size_t)tok * 128 + 64 + lane];
        float acc[16];
#pragma unroll
        for (int i = 0; i < 16; ++i) acc[i] = 0.f;
        u32x4 ua[4], va[4], ub[4], vb[4];
        pg_load(U, V, e0, 0, lane, ua, va);
#pragma unroll 1
        for (int bi = 0; bi < 32; bi += 2) {
            pg_load(U, V, (bi + 1 < 16) ? e0 : e1, ((bi + 1) & 15) * 4, lane, ub, vb);
            pg_comp(ua, va, xf, acc, (bi < 16) ? g0 : g1, (bi & 15) * 4, lane);
            if (bi + 2 < 32) pg_load(U, V, (bi + 2 < 16) ? e0 : e1, ((bi + 2) & 15) * 4, lane, ua, va);
            pg_comp(ub, vb, xf, acc, (bi + 1 < 16) ? g0 : g1, ((bi + 1) & 15) * 4, lane);
        }
        const float* op = p.out + (size_t)tok * 1024 + lane * 16; float* dp = dst + (size_t)tok * 1024 + lane * 16;
#pragma unroll
        for (int q4 = 0; q4 < 4; ++q4) { f32x4 o = *(const f32x4*)(op + q4 * 4);
            o[0] += acc[q4 * 4]; o[1] += acc[q4 * 4 + 1]; o[2] += acc[q4 * 4 + 2]; o[3] += acc[q4 * 4 + 3]; *(f32x4*)(dp + q4 * 4) = o; }
    }
}

__device__ __forceinline__ void pu_compute(const u32x4 (&ur)[8], const u32x4 xa, const u32x4 xb, float gs0, float gs1, float gs2, float gs3, float gs4, float gs5, float gs6, float gs7, int pos0, int pos1, int pos2, int pos3, int pos4, int pos5, int pos6, int pos7, float* wts, int lane) {
    const bool b5 = lane & 32, b4 = lane & 16, b3 = lane & 8;
    float xf[16]; unpack8(xa, xf); unpack8(xb, xf + 8);
    float d[8];
#pragma unroll
    for (int k = 0; k < 8; ++k) { float uf[16]; fp8x16(ur[k], uf); float sacc = 0.f;
#pragma unroll
        for (int i = 0; i < 16; ++i) sacc += uf[i] * xf[i];
        d[k] = sacc; }
    float r4[4], r2[2], r1;
#pragma unroll
    for (int i = 0; i < 4; ++i) { const float a = b5 ? d[i + 4] : d[i], bb = b5 ? d[i] : d[i + 4]; r4[i] = a + __shfl_xor(bb, 32); }
#pragma unroll
    for (int i = 0; i < 2; ++i) { const float a = b4 ? r4[i + 2] : r4[i], bb = b4 ? r4[i] : r4[i + 2]; r2[i] = a + __shfl_xor(bb, 16); }
    { const float a = b3 ? r2[1] : r2[0], bb = b3 ? r2[0] : r2[1]; r1 = a + __shfl_xor(bb, 8); }
    r1 += __shfl_xor(r1, 4); r1 += __shfl_xor(r1, 2); r1 += __shfl_xor(r1, 1);
    r1 *= (1.0f / 256.0f);
    const float gt = b5 ? (b4 ? (b3 ? gs7 : gs6) : (b3 ? gs5 : gs4)) : (b4 ? (b3 ? gs3 : gs2) : (b3 ? gs1 : gs0));
    const int ps = b5 ? (b4 ? (b3 ? pos7 : pos6) : (b3 ? pos5 : pos4)) : (b4 ? (b3 ? pos3 : pos2) : (b3 ? pos1 : pos0));
    const float w = gt * gelu_erf(r1) * (1.0f / 64.0f);
    if ((lane & 7) == 0 && ps >= 0) wts[ps] = w;
}
__device__ void phase_peer_u(const Params& p) {
    const int tid = otid(), lane = tid & 63, wv = tid >> 6;
    int bid = blockIdx.x; asm volatile("" : "+s"(bid));
    const int xs = bid & 7, slot = bid >> 3, nslot = gridDim.x >> 3;
    if (slot >= nslot) return;
    const int nwx = nslot * 8;
    const unsigned char* U = p.ws + WS_U; const bf16_t* xn = (const bf16_t*)(p.ws + WS_XN);
    const int* eid = (const int*)(p.ws + WS_MIXED); const float* gate = (const float*)(p.ws + WS_MIXED + 8 * MB);
    float* wts = (float*)(p.ws + WS_PROJ);
    int ntok = slot * 8 + wv, ctok = -1;
    int ne0 = -1, ne1 = -1, ce0 = -1, ce1 = -1; float ng0 = 0.f, ng1 = 0.f, cg0 = 0.f, cg1 = 0.f; u32x4 nxa = {0u, 0u, 0u, 0u}, nxb = nxa, cxa = nxa, cxb = nxa;
    unsigned long long m0 = 0ull, m1 = 0ull;
#define PU_LOADTOK() do { if (ntok < T_) { ne0 = eid[(size_t)ntok * 128 + lane]; ne1 = eid[(size_t)ntok * 128 + 64 + lane]; ng0 = gate[(size_t)ntok * 128 + lane]; ng1 = gate[(size_t)ntok * 128 + 64 + lane]; \
            const u32x4* xp_ = (const u32x4*)(xn + (size_t)ntok * 1024 + lane * 16); nxa = xp_[0]; nxb = xp_[1]; } } while (0)
#define PU_POP(I_, G_, P_) do { \
            if (m0) { const int l = __builtin_ctzll(m0); m0 &= m0 - 1ull; I_ = __builtin_amdgcn_readlane(ce0, l); G_ = __int_as_float(__builtin_amdgcn_readlane(__float_as_int(cg0), l)); P_ = ctok * 128 + l; last_ = I_; } \
            else if (m1) { const int l = __builtin_ctzll(m1); m1 &= m1 - 1ull; I_ = __builtin_amdgcn_readlane(ce1, l); G_ = __int_as_float(__builtin_amdgcn_readlane(__float_as_int(cg1), l)); P_ = ctok * 128 + 64 + l; last_ = I_; } \
            else { I_ = last_; G_ = 0.f; P_ = -1; } } while (0)
#define PU_NEXT(HAS, ID, GS, POS, XA, XB) do { HAS = true; \
        while ((m0 | m1) == 0ull) { if (ntok >= T_) { HAS = false; break; } \
            ctok = ntok; ce0 = ne0; ce1 = ne1; cg0 = ng0; cg1 = ng1; cxa = nxa; cxb = nxb; \
            m0 = __ballot((ce0 >> 11) == xs); m1 = __ballot((ce1 >> 11) == xs); ntok += nwx; PU_LOADTOK(); } \
        if (HAS) { int last_ = 0; \
            PU_POP(ID##0, GS##0, POS##0); PU_POP(ID##1, GS##1, POS##1); PU_POP(ID##2, GS##2, POS##2); PU_POP(ID##3, GS##3, POS##3); PU_POP(ID##4, GS##4, POS##4); PU_POP(ID##5, GS##5, POS##5); PU_POP(ID##6, GS##6, POS##6); PU_POP(ID##7, GS##7, POS##7); \
          XA = cxa; XB = cxb; } } while (0)
#define PU_ROWS(ID, UR) do { UR[0] = *(const u32x4*)(U + (size_t)ID##0 * 1024 + lane * 16); UR[1] = *(const u32x4*)(U + (size_t)ID##1 * 1024 + lane * 16); UR[2] = *(const u32x4*)(U + (size_t)ID##2 * 1024 + lane * 16); UR[3] = *(const u32x4*)(U + (size_t)ID##3 * 1024 + lane * 16); UR[4] = *(const u32x4*)(U + (size_t)ID##4 * 1024 + lane * 16); UR[5] = *(const u32x4*)(U + (size_t)ID##5 * 1024 + lane * 16); UR[6] = *(const u32x4*)(U + (size_t)ID##6 * 1024 + lane * 16); UR[7] = *(const u32x4*)(U + (size_t)ID##7 * 1024 + lane * 16); } while (0)
    PU_LOADTOK();
    int ida0 = 0, idb0 = 0, posa0 = -1, posb0 = -1, ida1 = 0, idb1 = 0, posa1 = -1, posb1 = -1, ida2 = 0, idb2 = 0, posa2 = -1, posb2 = -1, ida3 = 0, idb3 = 0, posa3 = -1, posb3 = -1, ida4 = 0, idb4 = 0, posa4 = -1, posb4 = -1, ida5 = 0, idb5 = 0, posa5 = -1, posb5 = -1, ida6 = 0, idb6 = 0, posa6 = -1, posb6 = -1, ida7 = 0, idb7 = 0, posa7 = -1, posb7 = -1;
    float gsa0 = 0.f, gsb0 = 0.f, gsa1 = 0.f, gsb1 = 0.f, gsa2 = 0.f, gsb2 = 0.f, gsa3 = 0.f, gsb3 = 0.f, gsa4 = 0.f, gsb4 = 0.f, gsa5 = 0.f, gsb5 = 0.f, gsa6 = 0.f, gsb6 = 0.f, gsa7 = 0.f, gsb7 = 0.f; u32x4 xaa = cxa, xab = cxa, xba = cxa, xbb = cxa, ua[8], ub[8];
    bool ha, hb;
    PU_NEXT(ha, ida, gsa, posa, xaa, xab);
    if (ha) PU_ROWS(ida, ua);
    while (ha) {
        PU_NEXT(hb, idb, gsb, posb, xba, xbb);
        if (hb) PU_ROWS(idb, ub);
        pu_compute(ua, xaa, xab, gsa0, gsa1, gsa2, gsa3, gsa4, gsa5, gsa6, gsa7, posa0, posa1, posa2, posa3, posa4, posa5, posa6, posa7, wts, lane);
        if (!hb) break;
        PU_NEXT(ha, ida, gsa, posa, xaa, xab);
        if (ha) PU_ROWS(ida, ua);
        pu_compute(ub, xba, xbb, gsb0, gsb1, gsb2, gsb3, gsb4, gsb5, gsb6, gsb7, posb0, posb1, posb2, posb3, posb4, posb5, posb6, posb7, wts, lane);
    }
#undef PU_LOADTOK
#undef PU_NEXT
#undef PU_POP
#undef PU_ROWS
}
__device__ __forceinline__ void peer_sorted_token(const Params& p, int tok, int lane, int& e0, int& e1, float& g0, float& g1) {
    const int* eid = (const int*)(p.ws + WS_MIXED); const float* gate = (const float*)(p.ws + WS_MIXED + 8 * MB);
    e0 = eid[(size_t)tok * 128 + lane]; e1 = eid[(size_t)tok * 128 + 64 + lane];
    g0 = gate[(size_t)tok * 128 + lane]; g1 = gate[(size_t)tok * 128 + 64 + lane];
    unsigned k0 = ((unsigned)e0 << 7) | (unsigned)lane, k1 = ((unsigned)e1 << 7) | (unsigned)(64 + lane);
#pragma unroll
    for (int k = 2; k <= 128; k <<= 1) {
#pragma unroll
        for (int j = k >> 1; j >= 1; j >>= 1) {
            if (j == 64) { const unsigned lo = min(k0, k1), hi = max(k0, k1); k0 = lo; k1 = hi; }
            else { const unsigned o0 = (unsigned)__shfl_xor((int)k0, j), o1 = (unsigned)__shfl_xor((int)k1, j);
                const bool lower = (lane & j) == 0, up0 = (lane & k) == 0, up1 = ((64 + lane) & k) == 0;
                k0 = (lower == up0) ? min(k0, o0) : max(k0, o0); k1 = (lower == up1) ? min(k1, o1) : max(k1, o1); }
        }
    }
    const int s0 = (int)(k0 & 127u), s1 = (int)(k1 & 127u);
    const float ga0 = __shfl(g0, s0 & 63), gb0 = __shfl(g1, s0 & 63), ga1 = __shfl(g0, s1 & 63), gb1 = __shfl(g1, s1 & 63);
    e0 = (int)(k0 >> 7); e1 = (int)(k1 >> 7); g0 = (s0 < 64) ? ga0 : gb0; g1 = (s1 < 64) ? ga1 : gb1;
    int* eidw = (int*)(p.ws + WS_MIXED); eidw[(size_t)tok * 128 + lane] = e0; eidw[(size_t)tok * 128 + 64 + lane] = e1;
}
__device__ void phase_peer_u_tok(const Params& p) {
    const int lane = otid() & 63, wg = blockIdx.x * 8 + (otid() >> 6), nw = gridDim.x * 8;
    const unsigned char* U = p.ws + WS_U; const bf16_t* xn = (const bf16_t*)(p.ws + WS_XN);
    float* wts = (float*)(p.ws + WS_PROJ);
    const bool b5 = lane & 32, b4 = lane & 16, b3 = lane & 8;
    const int kmine = ((lane >> 5) & 1) * 4 + ((lane >> 4) & 1) * 2 + ((lane >> 3) & 1);
    int rnd = 0;
    for (int tbase = wg; tbase < T_; tbase += 4 * nw, ++rnd) {
        const int rev = (rnd & 1) ? 15 : 0;
        const bool has0 = tbase + 0 * nw < T_; const int tok0 = has0 ? tbase + 0 * nw : tbase;
        const bool has1 = tbase + 1 * nw < T_; const int tok1 = has1 ? tbase + 1 * nw : tbase;
        const bool has2 = tbase + 2 * nw < T_; const int tok2 = has2 ? tbase + 2 * nw : tbase;
        const bool has3 = tbase + 3 * nw < T_; const int tok3 = has3 ? tbase + 3 * nw : tbase;
        u32x4 xa0, xb0; { const u32x4* xp = (const u32x4*)(xn + (size_t)tok0 * 1024 + lane * 16); xa0 = xp[0]; xb0 = xp[1]; }
        u32x4 xa1, xb1; { const u32x4* xp = (const u32x4*)(xn + (size_t)tok1 * 1024 + lane * 16); xa1 = xp[0]; xb1 = xp[1]; }
        u32x4 xa2, xb2; { const u32x4* xp = (const u32x4*)(xn + (size_t)tok2 * 1024 + lane * 16); xa2 = xp[0]; xb2 = xp[1]; }
        u32x4 xa3, xb3; { const u32x4* xp = (const u32x4*)(xn + (size_t)tok3 * 1024 + lane * 16); xa3 = xp[0]; xb3 = xp[1]; }
        int e00, e01; float g00, g01; peer_sorted_token(p, tok0, lane, e00, e01, g00, g01);
        int e10, e11; float g10, g11; if (has1) peer_sorted_token(p, tok1, lane, e10, e11, g10, g11); else { e10 = e00; e11 = e01; g10 = 0.f; g11 = 0.f; }
        int e20, e21; float g20, g21; if (has2) peer_sorted_token(p, tok2, lane, e20, e21, g20, g21); else { e20 = e00; e21 = e01; g20 = 0.f; g21 = 0.f; }
        int e30, e31; float g30, g31; if (has3) peer_sorted_token(p, tok3, lane, e30, e31, g30, g31); else { e30 = e00; e31 = e01; g30 = 0.f; g31 = 0.f; }
        u32x4 ua[8], ub[8];
#define PUT_LD(bi_, U_, E0_, E1_) do { const int es_ = ((bi_) < 8) ? E0_ : E1_; _Pragma("unroll") for (int k = 0; k < 8; ++k) { const int id = __builtin_amdgcn_readlane(es_, ((bi_) & 7) * 8 + k); U_[k] = *(const u32x4*)(U + (size_t)id * 1024 + lane * 16); } } while (0)
#define PUT_CP(bi_, U_, XA_, XB_, G0_, G1_, TOK_, ST_) do { float xf_[16]; unpack8(XA_, xf_); unpack8(XB_, xf_ + 8); f32x2 x2_[8]; _Pragma("unroll") for (int i = 0; i < 8; ++i) x2_[i] = (f32x2){xf_[2 * i], xf_[2 * i + 1]}; float d[8]; _Pragma("unroll") for (int k = 0; k < 8; ++k) { f32x2 uf[8]; fp8x16_pk(U_[k], uf); f32x2 sacc = uf[0] * x2_[0]; _Pragma("unroll") for (int i = 1; i < 8; ++i) sacc = __builtin_elementwise_fma(uf[i], x2_[i], sacc); d[k] = sacc[0] + sacc[1]; } \
            float r4[4], r2[2], r1; \
            _Pragma("unroll") for (int i = 0; i < 4; ++i) { const float a = b5 ? d[i + 4] : d[i], bb = b5 ? d[i] : d[i + 4]; r4[i] = a + __shfl_xor(bb, 32); } \
            _Pragma("unroll") for (int i = 0; i < 2; ++i) { const float a = b4 ? r4[i + 2] : r4[i], bb = b4 ? r4[i] : r4[i + 2]; r2[i] = a + __shfl_xor(bb, 16); } \
            { const float a = b3 ? r2[1] : r2[0], bb = b3 ? r2[0] : r2[1]; r1 = a + __shfl_xor(bb, 8); } \
            r1 += __shfl_xor(r1, 4); r1 += __shfl_xor(r1, 2); r1 += __shfl_xor(r1, 1); r1 *= (1.0f / 256.0f); \
            const float gt = __shfl(((bi_) < 8) ? G0_ : G1_, ((bi_) & 7) * 8 + kmine); \
            if ((lane & 7) == 0 && (ST_)) wts[(size_t)(TOK_) * 128 + (bi_) * 8 + kmine] = gt * gelu_erf(r1) * (1.0f / 64.0f); } while (0)
        PUT_LD(0 ^ rev, ua, e00, e01);
#pragma unroll 1
        for (int bi = 0; bi < 16; ++bi) {
            PUT_LD(bi ^ rev, ub, e10, e11);
            PUT_CP(bi ^ rev, ua, xa0, xb0, g00, g01, tok0, has0);
            PUT_LD(bi ^ rev, ua, e20, e21);
            PUT_CP(bi ^ rev, ub, xa1, xb1, g10, g11, tok1, has1);
            PUT_LD(bi ^ rev, ub, e30, e31);
            PUT_CP(bi ^ rev, ua, xa2, xb2, g20, g21, tok2, has2);
            if (bi + 1 < 16) PUT_LD((bi + 1) ^ rev, ua, e00, e01);
            PUT_CP(bi ^ rev, ub, xa3, xb3, g30, g31, tok3, has3);
        }
#undef PUT_LD
#undef PUT_CP
    }
}
__device__ void phase_peer_v(const Params& p) {
    const int lane = otid() & 63, wg = blockIdx.x * 8 + (otid() >> 6), nw = gridDim.x * 8;
    const unsigned char* V = p.ws + WS_V;
    const int* eid = (const int*)(p.ws + WS_MIXED); const float* wts = (const float*)(p.ws + WS_PROJ);
    int rnd = 0;
    for (int tbase = wg; tbase < T_; tbase += 4 * nw, ++rnd) {
        const int rev = (rnd & 1) ? 31 : 0;
        const bool has0 = tbase + 0 * nw < T_; const int tok0 = has0 ? tbase + 0 * nw : tbase;
        const bool has1 = tbase + 1 * nw < T_; const int tok1 = has1 ? tbase + 1 * nw : tbase;
        const bool has2 = tbase + 2 * nw < T_; const int tok2 = has2 ? tbase + 2 * nw : tbase;
        const bool has3 = tbase + 3 * nw < T_; const int tok3 = has3 ? tbase + 3 * nw : tbase;
        const int e00 = eid[(size_t)tok0 * 128 + lane], e01 = eid[(size_t)tok0 * 128 + 64 + lane]; const float w00 = wts[(size_t)tok0 * 128 + lane], w01 = wts[(size_t)tok0 * 128 + 64 + lane];
        f32x2 acc0[8];
#pragma unroll
        for (int i = 0; i < 8; ++i) acc0[i] = (f32x2){0.f, 0.f};
        const int e10 = eid[(size_t)tok1 * 128 + lane], e11 = eid[(size_t)tok1 * 128 + 64 + lane]; const float w10 = wts[(size_t)tok1 * 128 + lane], w11 = wts[(size_t)tok1 * 128 + 64 + lane];
        f32x2 acc1[8];
#pragma unroll
        for (int i = 0; i < 8; ++i) acc1[i] = (f32x2){0.f, 0.f};
        const int e20 = eid[(size_t)tok2 * 128 + lane], e21 = eid[(size_t)tok2 * 128 + 64 + lane]; const float w20 = wts[(size_t)tok2 * 128 + lane], w21 = wts[(size_t)tok2 * 128 + 64 + lane];
        f32x2 acc2[8];
#pragma unroll
        for (int i = 0; i < 8; ++i) acc2[i] = (f32x2){0.f, 0.f};
        const int e30 = eid[(size_t)tok3 * 128 + lane], e31 = eid[(size_t)tok3 * 128 + 64 + lane]; const float w30 = wts[(size_t)tok3 * 128 + lane], w31 = wts[(size_t)tok3 * 128 + 64 + lane];
        f32x2 acc3[8];
#pragma unroll
        for (int i = 0; i < 8; ++i) acc3[i] = (f32x2){0.f, 0.f};
        u32x4 va[4], vb[4];
#define PV_LD(bi_, V_, E0_, E1_) do { const int es_ = ((bi_) < 16) ? E0_ : E1_; _Pragma("unroll") for (int k = 0; k < 4; ++k) { const int id = __builtin_amdgcn_readlane(es_, ((bi_) & 15) * 4 + k); V_[k] = *(const u32x4*)(V + (size_t)id * 1024 + lane * 16); } } while (0)
#define PV_CP(bi_, V_, W0_, W1_, ACC_) do { const float ws_ = ((bi_) < 16) ? W0_ : W1_; _Pragma("unroll") for (int k = 0; k < 4; ++k) { const float wk = __int_as_float(__builtin_amdgcn_readlane(__float_as_int(ws_), ((bi_) & 15) * 4 + k)); \
            f32x2 vf[8]; fp8x16_pk(V_[k], vf); const f32x2 wk2 = (f32x2){wk, wk}; _Pragma("unroll") for (int i = 0; i < 8; ++i) ACC_[i] = __builtin_elementwise_fma(vf[i], wk2, ACC_[i]); } } while (0)
        PV_LD(0 ^ rev, va, e00, e01);
#pragma unroll 1
        for (int bi = 0; bi < 32; ++bi) {
            PV_LD(bi ^ rev, vb, e10, e11);
            PV_CP(bi ^ rev, va, w00, w01, acc0);
            PV_LD(bi ^ rev, va, e20, e21);
            PV_CP(bi ^ rev, vb, w10, w11, acc1);
            PV_LD(bi ^ rev, vb, e30, e31);
            PV_CP(bi ^ rev, va, w20, w21, acc2);
            if (bi + 1 < 32) PV_LD((bi + 1) ^ rev, va, e00, e01);
            PV_CP(bi ^ rev, vb, w30, w31, acc3);
        }
#undef PV_LD
#undef PV_CP
        if (has0) { float* op = p.out + (size_t)tok0 * 1024 + lane * 16;
#pragma unroll
          for (int q4 = 0; q4 < 4; ++q4) { f32x4 o = *(const f32x4*)(op + q4 * 4);
              o[0] += acc0[q4 * 2][0]; o[1] += acc0[q4 * 2][1]; o[2] += acc0[q4 * 2 + 1][0]; o[3] += acc0[q4 * 2 + 1][1]; *(f32x4*)(op + q4 * 4) = o; } }
        if (has1) { float* op = p.out + (size_t)tok1 * 1024 + lane * 16;
#pragma unroll
          for (int q4 = 0; q4 < 4; ++q4) { f32x4 o = *(const f32x4*)(op + q4 * 4);
              o[0] += acc1[q4 * 2][0]; o[1] += acc1[q4 * 2][1]; o[2] += acc1[q4 * 2 + 1][0]; o[3] += acc1[q4 * 2 + 1][1]; *(f32x4*)(op + q4 * 4) = o; } }
        if (has2) { float* op = p.out + (size_t)tok2 * 1024 + lane * 16;
#pragma unroll
          for (int q4 = 0; q4 < 4; ++q4) { f32x4 o = *(const f32x4*)(op + q4 * 4);
              o[0] += acc2[q4 * 2][0]; o[1] += acc2[q4 * 2][1]; o[2] += acc2[q4 * 2 + 1][0]; o[3] += acc2[q4 * 2 + 1][1]; *(f32x4*)(op + q4 * 4) = o; } }
        if (has3) { float* op = p.out + (size_t)tok3 * 1024 + lane * 16;
#pragma unroll
          for (int q4 = 0; q4 < 4; ++q4) { f32x4 o = *(const f32x4*)(op + q4 * 4);
              o[0] += acc3[q4 * 2][0]; o[1] += acc3[q4 * 2][1]; o[2] += acc3[q4 * 2 + 1][0]; o[3] += acc3[q4 * 2 + 1][1]; *(f32x4*)(op + q4 * 4) = o; } }
    }
}

constexpr size_t WS_BAR = 239 * MB;
#define XB_TMO      128
#define XB_XCNT(j)  (256  + 64 * (j))
#define XB_XSUB(j)  (1280 + 64 * (j))
#define XB_XGEN(j)  (2304 + 64 * (j))
#define XB_TOP      3328
#define XB_TOPGEN   3392
#define XCD_BAR_WORDS 3456
#define XB_SPIN_CAP (1u << 18)
__device__ __forceinline__ unsigned xb_ld(unsigned* p)              { return __hip_atomic_load(p, __ATOMIC_RELAXED, __HIP_MEMORY_SCOPE_AGENT); }
__device__ __forceinline__ unsigned xb_add(unsigned* p, unsigned v) { return __hip_atomic_fetch_add(p, v, __ATOMIC_RELAXED, __HIP_MEMORY_SCOPE_AGENT); }
__device__ __forceinline__ unsigned xb_xcc_id() { return (unsigned)__builtin_amdgcn_s_getreg((3 << 11) | 20) & 0xFu; }
#define XB_SPIN(cond, bar) do { unsigned _sp = 0; while (cond) { __builtin_amdgcn_s_sleep(1); \
    if ((++_sp & 255u) == 0u) { if (xb_ld(&(bar)[XB_TMO])) break; if (_sp > XB_SPIN_CAP) { atomicAdd(&(bar)[XB_TMO], 1u); break; } } } } while (0)
struct XcdBarrier { unsigned* bar; unsigned x; volatile LAS unsigned* st; };
__device__ __forceinline__ XcdBarrier xcd_barrier_post(unsigned* bar, volatile LAS unsigned* st) {
    XcdBarrier b; b.bar = bar; b.x = xb_xcc_id(); b.st = st;
    if (threadIdx.x == 0) (void)xb_add(&bar[XB_XCNT(b.x)], 1u);
    return b;
}
__device__ __forceinline__ void xcd_barrier_complete(unsigned* bar, unsigned x, unsigned& nloc, unsigned& nx) {
    const unsigned G = gridDim.x * gridDim.y * gridDim.z;
    unsigned sum, cnt, mine, sp = 0u;
    for (;;) {
        sum = 0u; cnt = 0u; mine = 0u;
#pragma unroll
        for (unsigned j = 0; j < 16; ++j) { const unsigned c = xb_ld(&bar[XB_XCNT(j)]); sum += c; cnt += (c > 0u) ? 1u : 0u; mine = (j == x) ? c : mine; }
        if (sum == G) break;
        __builtin_amdgcn_s_sleep(1);
        if ((++sp & 255u) == 0u) { if (xb_ld(&bar[XB_TMO])) break; if (sp > XB_SPIN_CAP) { atomicAdd(&bar[XB_TMO], 1u); break; } }
    }
    nloc = mine > 0u ? mine : 1u; nx = cnt > 0u ? cnt : 1u;
}
__device__ __forceinline__ void xcd_barrier(const XcdBarrier& b) {
    asm volatile("s_waitcnt vmcnt(0)" ::: "memory");
    __syncthreads();
    if (threadIdx.x == 0) {
        unsigned* bar = b.bar;
        __builtin_amdgcn_s_waitcnt(0);
        unsigned nloc = b.st[0], nx = b.st[1];
        if (nloc == 0u) { xcd_barrier_complete(bar, b.x, nloc, nx); b.st[0] = nloc; b.st[1] = nx; }
        const unsigned old = xb_add(&bar[XB_XSUB(b.x)], 1u);
        const unsigned gen = old / nloc;
        if (old + 1u == (gen + 1u) * nloc) {
            __builtin_amdgcn_fence(__ATOMIC_RELEASE, "agent");
            asm volatile("s_waitcnt vmcnt(0)" ::: "memory");
            const unsigned og = xb_add(&bar[XB_TOP], 1u);
            const unsigned tg = og / nx;
            if (og + 1u == (tg + 1u) * nx) xb_add(&bar[XB_TOPGEN], 1u);
            else XB_SPIN(xb_ld(&bar[XB_TOPGEN]) == tg, bar);
            __builtin_amdgcn_fence(__ATOMIC_ACQUIRE, "agent");
            xb_add(&bar[XB_XGEN(b.x)], 1u);
            asm volatile("s_waitcnt vmcnt(0)" ::: "memory");
        } else {
            XB_SPIN(xb_ld(&bar[XB_XGEN(b.x)]) == gen, bar);
            __builtin_amdgcn_fence(__ATOMIC_ACQUIRE, "agent");
            asm volatile("s_waitcnt vmcnt(0)" ::: "memory");
        }
    }
    __syncthreads();
}
__device__ __forceinline__ void seam(const XcdBarrier& xb, int k) {
    asm volatile("" : "+s"(k));
    if (k < 0) cg::this_grid().sync();
    else xcd_barrier(xb);
}

__global__ void __launch_bounds__(NTHR, 2) fwd_kernel(Params p) {
    extern __shared__ __attribute__((aligned(16))) unsigned char shm[];
    __shared__ uint4 xb_words;
    if (threadIdx.x == 0) xb_words = make_uint4(0u, 0u, 0u, 0u);
    __syncthreads();
    const XcdBarrier xb = xcd_barrier_post((unsigned*)(p.ws + WS_BAR), (volatile LAS unsigned*)&xb_words);
#ifndef PH_MASK
#define PH_MASK 0x7ff
#endif
#define PH_ON(n) ((PH_MASK >> (n)) & 1)
#define PHASE(n) if (PH_ON(n) && (n) >= p.ph_lo && (n) < p.ph_hi && (((n) > p.ph_lo) ? (seam(xb, (n)), true) : true))
    PHASE(0) {
#pragma unroll 1
        for (int rep = 0; rep < REP0; ++rep) { if (rep) cg::this_grid().sync();   phase_prep(p, shm); } }
    PHASE(1) for (int rep = 0; rep < REPG; ++rep) { if (rep) cg::this_grid().sync();   pg8::Gemm gm{(const bf16_t*)(p.ws + WS_XN), (const bf16_t*)(p.ws + WS_WIN), T_, NPROJ, D_}; pg8::StaticOrder so; so.init(T_, NPROJ, gridDim.x, blockIdx.x);
               pg8::EpiBf16Out ep{(bf16_t*)(p.ws + WS_PROJ), NPROJ}; pg8::gemm_phase((LAS unsigned char*)shm, gm, so, ep); }
    PHASE(2) phase_mixprep(p, shm);
    PHASE(3) { gla_scan(p);
#pragma unroll 1
        for (int rep = 0; rep < REP3; ++rep) { if (rep) cg::this_grid().sync();   phase_moba(p, shm); } }
    PHASE(4) {
#pragma unroll 1
        for (int rep = 0; rep < REP4; ++rep) { if (rep) cg::this_grid().sync();   phase_gla_out(p); } }
    PHASE(5) for (int rep = 0; rep < REPG; ++rep) { if (rep) cg::this_grid().sync();   pg8::Gemm gm{(const bf16_t*)(p.ws + WS_MIXED), (const bf16_t*)(p.ws + WS_WOUT), T_, D_, D_}; pg8::StaticOrder so; so.init(T_, D_, gridDim.x, blockIdx.x);
               pg8::EpiResF32 ep{p.out, p.x, D_}; pg8::gemm_phase((LAS unsigned char*)shm, gm, so, ep); }
    PHASE(6) {
#pragma unroll 1
        for (int rep = 0; rep < REP4; ++rep) { if (rep) cg::this_grid().sync();   rmsnorm_rows<false, true>(p.out, p.norm2_w, (bf16_t*)(p.ws + WS_XN), nullptr, nullptr, (unsigned*)(p.ws + WS_XQ8), (float*)(p.ws + WS_SX)); } }
    PHASE(7) for (int rep = 0; rep < REPG; ++rep) { if (rep) cg::this_grid().sync();   pg8::Gemm gm{(const bf16_t*)(p.ws + WS_XQ8), (const bf16_t*)(p.ws + WS_WQ8), T_, 2048, D_ / 2}; pg8::StaticOrder so; so.init(T_, 2048, gridDim.x, blockIdx.x);
               pg8::EpiBf16OutI8 ep{(bf16_t*)(p.ws + WS_PROJ), 2048, (const float*)(p.ws + WS_SX), (const float*)(p.ws + WS_SW)}; pg8::gemm_phase((LAS unsigned char*)shm, gm, so, ep); }
    PHASE(8) {
#pragma unroll 1
        for (int rep = 0; rep < REP8; ++rep) { if (rep) cg::this_grid().sync();   phase_peer_topk(p, shm); } }
#if SPLIT_GATHER
#if SPLIT_GATHER == 2
    PHASE(9) phase_peer_u_tok(p);
#else
    PHASE(9) phase_peer_u(p);
#endif
    PHASE(10) phase_peer_v(p);
#else
    PHASE(9) phase_peer_gather(p, p.out);
#endif
}

extern "C" void kernel_launch(void* const* d_in, const int* in_sizes, int n_in, void* d_out, int out_size, void* d_ws, size_t ws_size, hipStream_t stream) {
    static int grid = 0;
    if (grid == 0) {
        int dev = 0, cus = 0, per_cu = 0;
        (void)hipGetDevice(&dev);
        (void)hipDeviceGetAttribute(&cus, hipDeviceAttributeMultiprocessorCount, dev);
        if (hipFuncSetAttribute((const void*)fwd_kernel, hipFuncAttributeMaxDynamicSharedMemorySize, LDS_BYTES) != hipSuccess) fprintf(stderr, "hipFuncSetAttribute failed\n");
        (void)hipOccupancyMaxActiveBlocksPerMultiprocessor(&per_cu, (const void*)fwd_kernel, NTHR, LDS_BYTES);
        if (per_cu < 1) per_cu = 1;
        grid = cus * 1;
        (void)hipGetLastError();
        if (ws_size < WS_END) fprintf(stderr, "workspace too small: %zu\n", ws_size);
    }
    Params p{};
    p.x = (const float*)d_in[0]; p.norm1_w = (const float*)d_in[1]; p.w_in = (const float*)d_in[2]; p.w_alpha = (const float*)d_in[3]; p.b_alpha = (const float*)d_in[4];
    p.gla_onw = (const float*)d_in[5]; p.mqw = (const float*)d_in[6]; p.mkw = (const float*)d_in[7]; p.mix_scale = (const float*)d_in[8]; p.w_out = (const float*)d_in[9];
    p.norm2_w = (const float*)d_in[10]; p.w_query = (const float*)d_in[11]; p.subkeys = (const float*)d_in[12]; p.peer_u = (const float*)d_in[13]; p.peer_v = (const float*)d_in[14];
    p.out = (float*)d_out; p.ws = (unsigned char*)d_ws;
#if MEGA
    p.ph_lo = 0; p.ph_hi = 11;
    (void)hipMemsetAsync((unsigned char*)d_ws + WS_BAR, 0, 16384, stream);
    void* args[] = {&p};
    hipError_t e = hipLaunchCooperativeKernel((const void*)fwd_kernel, dim3(grid), dim3(NTHR), args, LDS_BYTES, stream);
    if (e != hipSuccess) fprintf(stderr, "cooperative launch failed: %s (grid %d)\n", hipGetErrorString(e), grid);
#else
    for (int ph = 0; ph < 10; ++ph) { p.ph_lo = ph; p.ph_hi = ph + 1; hipLaunchKernelGGL(fwd_kernel, dim3(grid), dim3(NTHR), LDS_BYTES, stream, p); }
#endif
}
```
